# Optimizing an MI355X kernel written in HIP

```python
import math
import jax, jax.numpy as jnp
from jax import lax
import numpy as np

D_MODEL = 4096
BATCH = 4
SEQ = 4096
DEPTH = 2

HEAD_DIM = 128
BLOCK_Q = 128
SSM_GROUP = 16
SSM_STATE = 64
W_SSM = D_MODEL // 2
SSM_GROUPS = W_SSM // SSM_GROUP
SB_HEADS = (D_MODEL - W_SSM) // HEAD_DIM
W_SB = SB_HEADS * HEAD_DIM
EVEN_IN = W_SSM + 3 * W_SB
EVEN_OUT = W_SSM + W_SB
FOX_HEADS = D_MODEL // HEAD_DIM
FOX_WIDTH = FOX_HEADS * HEAD_DIM
FOX_IN = 3 * FOX_WIDTH + FOX_HEADS
D_FF = 4 * D_MODEL
N_EVEN = (DEPTH + 1) // 2
N_ODD = DEPTH // 2
DEEPNORM_ALPHA = (2.0 * DEPTH) ** 0.25
DEEPNORM_BETA = (8.0 * DEPTH) ** -0.25
LN_EPS = 1e-5
DT_MIN = 1e-3
DT_MAX = 1e-1
FORGET_BIAS_INIT = 2.0

kernel_name = "hybrid_s5_stickbreak_fox_deepnorm"


def layer_norm(x, g, b):
    xf = x.astype(jnp.float32)
    mu = jnp.mean(xf, axis=-1, keepdims=True)
    var = jnp.mean(jnp.square(xf - mu), axis=-1, keepdims=True)
    y = (xf - mu) * lax.rsqrt(var + LN_EPS) * g.astype(jnp.float32) + b.astype(jnp.float32)
    return y.astype(x.dtype)


def _split_heads(t, n_heads):
    b, s, _ = t.shape
    return t.reshape(b, s, n_heads, HEAD_DIM).transpose(0, 2, 1, 3)


def _to_blocks(t):
    b, h, s = t.shape[:3]
    nb = s // BLOCK_Q
    t = t.reshape((b, h, nb, BLOCK_Q) + t.shape[3:])
    return jnp.moveaxis(t, 2, 0)


def _merge_blocks(o):
    nb, b, h, blk, dh = o.shape
    return o.transpose(1, 0, 3, 2, 4).reshape(b, nb * blk, h * dh)


def _complex_affine_combine(e1, e2):
    a1r, a1i, b1r, b1i = e1
    a2r, a2i, b2r, b2i = e2
    ar = a2r * a1r - a2i * a1i
    ai = a2r * a1i + a2i * a1r
    br = a2r * b1r - a2i * b1i + b2r
    bi = a2r * b1i + a2i * b1r + b2i
    return ar, ai, br, bi


def s5_mixer(u, a_re, a_im, log_dt, b_re, b_im, c_re, c_im, d, w_glu):
    bsz, s, _ = u.shape
    uf = u.astype(jnp.float32).reshape(bsz, s, SSM_GROUPS, SSM_GROUP)
    lr = a_re.astype(jnp.float32)
    li = a_im.astype(jnp.float32)
    dt = jnp.exp(log_dt.astype(jnp.float32))[:, None]
    mag = jnp.exp(lr * dt)
    abar_r = mag * jnp.cos(li * dt)
    abar_i = mag * jnp.sin(li * dt)
    den = lr * lr + li * li
    nr = abar_r - 1.0
    ni = abar_i
    zr = (nr * lr + ni * li) / den
    zi = (ni * lr - nr * li) / den
    br = b_re.astype(jnp.float32)
    bi = b_im.astype(jnp.float32)
    bbar_r = zr[..., None] * br - zi[..., None] * bi
    bbar_i = zr[..., None] * bi + zi[..., None] * br
    bu_r = jnp.einsum('bsgp,gnp->bsgn', uf, bbar_r)
    bu_i = jnp.einsum('bsgp,gnp->bsgn', uf, bbar_i)
    ar = jnp.broadcast_to(abar_r, bu_r.shape)
    ai = jnp.broadcast_to(abar_i, bu_i.shape)
    _, _, xr, xi = lax.associative_scan(_complex_affine_combine, (ar, ai, bu_r, bu_i), axis=1)
    y = (jnp.einsum('bsgn,gpn->bsgp', xr, c_re.astype(jnp.float32))
         - jnp.einsum('bsgn,gpn->bsgp', xi, c_im.astype(jnp.float32))
         + d.astype(jnp.float32).reshape(SSM_GROUPS, SSM_GROUP) * uf)
    y = y.reshape(bsz, s, W_SSM).astype(u.dtype)
    g = jax.nn.gelu(y)
    return g * jax.nn.sigmoid(g @ w_glu)


def stick_breaking_attention(q, k, v):
    s = q.shape[2]
    nb = s // BLOCK_Q
    scale = HEAD_DIM ** -0.5
    key_pos = jnp.arange(s)

    def one_block(args):
        q_blk, blk = args
        z = jnp.einsum('bhqd,bhkd->bhqk', q_blk, k).astype(jnp.float32) * scale
        q_pos = blk * BLOCK_Q + jnp.arange(BLOCK_Q)
        earlier = key_pos[None, :] < q_pos[:, None]
        log_keep = jnp.where(earlier, jax.nn.log_sigmoid(-z), 0.0)
        log_between = lax.cumsum(log_keep, axis=3, reverse=True) - log_keep
        w = jnp.where(earlier, jnp.exp(jax.nn.log_sigmoid(z) + log_between), 0.0)
        return jnp.einsum('bhqk,bhkd->bhqd', w.astype(v.dtype), v)

    out = lax.map(one_block, (_to_blocks(q), jnp.arange(nb)))
    return _merge_blocks(out)


def forgetting_attention(q, k, v, cum):
    s = q.shape[2]
    nb = s // BLOCK_Q
    scale = HEAD_DIM ** -0.5
    key_pos = jnp.arange(s)

    def one_block(args):
        q_blk, c_blk, blk = args
        logits = (jnp.einsum('bhqd,bhkd->bhqk', q_blk, k).astype(jnp.float32) * scale
                  + c_blk[..., :, None] - cum[:, :, None, :])
        q_pos = blk * BLOCK_Q + jnp.arange(BLOCK_Q)
        causal = key_pos[None, :] <= q_pos[:, None]
        p = jax.nn.softmax(jnp.where(causal, logits, -jnp.inf), axis=-1)
        return jnp.einsum('bhqk,bhkd->bhqd', p.astype(v.dtype), v)

    out = lax.map(one_block, (_to_blocks(q), _to_blocks(cum), jnp.arange(nb)))
    return _merge_blocks(out)


def even_mixer(x, w_in, a_re, a_im, log_dt, b_re, b_im, c_re, c_im, d, w_glu, w_out):
    proj = x @ w_in
    u = proj[..., :W_SSM]
    q, k, v = jnp.split(proj[..., W_SSM:], 3, axis=-1)
    y_ssm = s5_mixer(u, a_re, a_im, log_dt, b_re, b_im, c_re, c_im, d, w_glu)
    y_sb = stick_breaking_attention(_split_heads(q, SB_HEADS), _split_heads(k, SB_HEADS),
                                    _split_heads(v, SB_HEADS))
    return jnp.concatenate([y_ssm, y_sb.astype(y_ssm.dtype)], axis=-1) @ w_out


def odd_mixer(x, w_in, b_f, w_out):
    proj = x @ w_in
    q, k, v = jnp.split(proj[..., :3 * FOX_WIDTH], 3, axis=-1)
    f_logit = proj[..., 3 * FOX_WIDTH:].astype(jnp.float32) + b_f.astype(jnp.float32)
    cum = jnp.cumsum(jax.nn.log_sigmoid(f_logit), axis=1).transpose(0, 2, 1)
    y = forgetting_attention(_split_heads(q, FOX_HEADS), _split_heads(k, FOX_HEADS),
                             _split_heads(v, FOX_HEADS), cum)
    return y.astype(x.dtype) @ w_out


def setup_inputs(seed: int = 0) -> dict:
    key = jax.random.key(seed)
    ks = jax.random.split(key, 21)
    nrm = jax.random.normal
    n_idx = jnp.arange(SSM_STATE, dtype=jnp.float32)
    return {
        'x': nrm(ks[0], (BATCH, SEQ, D_MODEL), jnp.float32),
        'even_w_in': nrm(ks[1], (N_EVEN, D_MODEL, EVEN_IN), jnp.float32) * D_MODEL ** -0.5,
        'ssm_a_re': -0.5 + 0.01 * nrm(ks[2], (N_EVEN, SSM_GROUPS, SSM_STATE), jnp.float32),
        'ssm_a_im': math.pi * n_idx + 0.01 * nrm(ks[3], (N_EVEN, SSM_GROUPS, SSM_STATE), jnp.float32),
        'ssm_log_dt': jax.random.uniform(ks[4], (N_EVEN, SSM_GROUPS), jnp.float32,
                                         minval=math.log(DT_MIN), maxval=math.log(DT_MAX)),
        'ssm_b_re': nrm(ks[5], (N_EVEN, SSM_GROUPS, SSM_STATE, SSM_GROUP), jnp.float32) * (2 * SSM_GROUP) ** -0.5,
        'ssm_b_im': nrm(ks[6], (N_EVEN, SSM_GROUPS, SSM_STATE, SSM_GROUP), jnp.float32) * (2 * SSM_GROUP) ** -0.5,
        'ssm_c_re': nrm(ks[7], (N_EVEN, SSM_GROUPS, SSM_GROUP, SSM_STATE), jnp.float32) * (2 * SSM_STATE) ** -0.5,
        'ssm_c_im': nrm(ks[8], (N_EVEN, SSM_GROUPS, SSM_GROUP, SSM_STATE), jnp.float32) * (2 * SSM_STATE) ** -0.5,
        'ssm_d': nrm(ks[9], (N_EVEN, W_SSM), jnp.float32),
        'ssm_w_glu': nrm(ks[10], (N_EVEN, W_SSM, W_SSM), jnp.float32) * W_SSM ** -0.5,
        'even_w_out': nrm(ks[11], (N_EVEN, EVEN_OUT, D_MODEL), jnp.float32) * EVEN_OUT ** -0.5 * DEEPNORM_BETA,
        'fox_w_in': nrm(ks[12], (N_ODD, D_MODEL, FOX_IN), jnp.float32) * D_MODEL ** -0.5,
        'fox_b_f': FORGET_BIAS_INIT + 0.1 * nrm(ks[13], (N_ODD, FOX_HEADS), jnp.float32),
        'fox_w_out': nrm(ks[14], (N_ODD, FOX_WIDTH, D_MODEL), jnp.float32) * FOX_WIDTH ** -0.5 * DEEPNORM_BETA,
        'ln_mix_g': 1.0 + 0.01 * nrm(ks[15], (DEPTH, D_MODEL), jnp.float32),
        'ln_mix_b': 0.01 * nrm(ks[16], (DEPTH, D_MODEL), jnp.float32),
        'mlp_w1': nrm(ks[17], (DEPTH, D_MODEL, D_FF), jnp.float32) * D_MODEL ** -0.5,
        'mlp_w2': nrm(ks[18], (DEPTH, D_FF, D_MODEL), jnp.float32) * D_FF ** -0.5 * DEEPNORM_BETA,
        'ln_ffn_g': 1.0 + 0.01 * nrm(ks[19], (DEPTH, D_MODEL), jnp.float32),
        'ln_ffn_b': 0.01 * nrm(ks[20], (DEPTH, D_MODEL), jnp.float32),
    }


def reference(x, even_w_in, ssm_a_re, ssm_a_im, ssm_log_dt, ssm_b_re, ssm_b_im, ssm_c_re,
              ssm_c_im, ssm_d, ssm_w_glu, even_w_out, fox_w_in, fox_b_f, fox_w_out,
              ln_mix_g, ln_mix_b, mlp_w1, mlp_w2, ln_ffn_g, ln_ffn_b):
    h = x
    for layer in range(DEPTH):
        i = layer // 2
        if layer % 2 == 0:
            mix = even_mixer(h, even_w_in[i], ssm_a_re[i], ssm_a_im[i], ssm_log_dt[i],
                             ssm_b_re[i], ssm_b_im[i], ssm_c_re[i], ssm_c_im[i], ssm_d[i],
                             ssm_w_glu[i], even_w_out[i])
        else:
            mix = odd_mixer(h, fox_w_in[i], fox_b_f[i], fox_w_out[i])
        h = layer_norm(DEEPNORM_ALPHA * h + mix.astype(h.dtype), ln_mix_g[layer], ln_mix_b[layer])
        ff = jnp.square(jax.nn.relu(h @ mlp_w1[layer])) @ mlp_w2[layer]
        h = layer_norm(DEEPNORM_ALPHA * h + ff, ln_ffn_g[layer], ln_ffn_b[layer])
    return h
```

```cpp
#include <hip/hip_runtime.h>
#include <cstdio>
#include <cstdint>

#ifndef MK_ONE_LAUNCH
#define MK_ONE_LAUNCH 1
#endif

#define LAS __attribute__((address_space(3)))
#define GAS __attribute__((address_space(1)))
#define AS4 __attribute__((address_space(4)))
typedef unsigned short bf16_t;
typedef short bf16x8 __attribute__((ext_vector_type(8)));
typedef short s16x4 __attribute__((ext_vector_type(4)));
typedef float f32x2 __attribute__((ext_vector_type(2)));
typedef float f32x4 __attribute__((ext_vector_type(4)));
typedef float f32x16 __attribute__((ext_vector_type(16)));
typedef unsigned u32x2 __attribute__((ext_vector_type(2)));
typedef unsigned u32x4 __attribute__((ext_vector_type(4)));

constexpr int DM = 4096, NB = 4, SEQ = 4096, MTOK = NB * SEQ;
constexpr int HD = 128;
constexpr int W_SSM = 2048, SSM_G = 128, SSM_P = 16, SSM_N = 64, SSM_L = 16;
constexpr int SB_H = 16, EVEN_IN = 8192, FOX_H = 32, FOX_IN = 12320, FOX_INP = 12544, DFF = 16384;
constexpr float ALPHA = 1.4142135623730951f;
constexpr float LN_EPS = 1e-5f;
constexpr float ATT_SCALE = 0.08838834764831845f;
constexpr int NWAVES = 8, NTHR = 512, BM_ = 256;
constexpr int UA_LD = 384;
constexpr int QKV0_LD = 6144, QKV1_LD = 12288;

constexpr size_t MiB = 1u << 20;
constexpr size_t WS_CTL = 0, CTL_ZERO_BYTES = 1 * MiB;
constexpr size_t WS_W_IN0 = 1 * MiB;
constexpr size_t WS_W_GLU = WS_W_IN0 + 64 * MiB;
constexpr size_t WS_W_OUT0 = WS_W_GLU + 8 * MiB;
constexpr size_t WS_W1_0 = WS_W_OUT0 + 32 * MiB;
constexpr size_t WS_W2_0 = WS_W1_0 + 128 * MiB;
constexpr size_t WS_W_IN1 = WS_W2_0 + 128 * MiB;
constexpr size_t WS_W_OUT1 = WS_W_IN1 + 98 * MiB;
constexpr size_t WS_W1_1 = WS_W_OUT1 + 32 * MiB;
constexpr size_t WS_W2_1 = WS_W1_1 + 128 * MiB;
constexpr size_t WS_BT2 = WS_W2_1 + 128 * MiB;
constexpr size_t WS_BT1 = WS_BT2 + 24 * MiB;
constexpr size_t WS_A16 = WS_BT1 + 16 * MiB;
constexpr size_t WS_FLOG = WS_A16 + 1 * MiB;
constexpr size_t WS_CB = WS_FLOG + 2 * MiB;
constexpr size_t WS_XB = WS_CB + 2 * MiB;
constexpr size_t WS_R = WS_XB + 128 * MiB;
constexpr size_t WS_UA = WS_R;
constexpr size_t WS_QKV0 = WS_UA + 96 * MiB;
constexpr size_t WS_XLOC = WS_QKV0 + 192 * MiB;
constexpr size_t WS_GACT = WS_XLOC + 64 * MiB;
constexpr size_t WS_CONCAT = WS_GACT + 64 * MiB;
constexpr size_t WS_HID = WS_R;
constexpr size_t WS_QKV1 = WS_R;
constexpr size_t WS_ATT = WS_R + 384 * MiB;
constexpr size_t WS_END = WS_R + 544 * MiB;
static_assert(WS_CONCAT + 128 * MiB == WS_END, "ws map");

constexpr int CW_BAR = 4096;
constexpr size_t WS_ST = 64 * 1024;
constexpr int ST_N = 16384;
static_assert(WS_ST + 6 * ST_N * 4 <= CTL_ZERO_BYTES, "s/t vectors inside the zeroed control region");
constexpr size_t WS_NRM = 512 * 1024;
constexpr size_t WS_DMIN = WS_NRM + 4096;
constexpr size_t WS_PS = WS_END;
constexpr size_t PS_STRIDE = (size_t)MTOK * 64;
constexpr size_t WS_SCR = WS_PS + 32 * MiB;
constexpr size_t WS_NEED = WS_SCR;

constexpr int RING_BYTES = 131072;
constexpr int MISC_OFF = RING_BYTES + 320;
constexpr int TBL_OFF = RING_BYTES + 1024;
constexpr int STB_OFF = RING_BYTES + 3072;
constexpr int KEY_WORD = 12;
constexpr int LDS_BYTES = 147456;

#define RLX_AGENT __ATOMIC_RELAXED, __HIP_MEMORY_SCOPE_AGENT
#define LDS_WAIT() asm volatile("s_waitcnt lgkmcnt(0)" ::: "memory")
#define VM_WAIT() asm volatile("s_waitcnt vmcnt(0)" ::: "memory")
__device__ __forceinline__ unsigned cvt_pk_bf16(float lo, float hi) { unsigned r; asm volatile("v_cvt_pk_bf16_f32 %0, %1, %2" : "=v"(r) : "v"(lo), "v"(hi)); return r; }
__device__ __forceinline__ unsigned f2bf(float f) { unsigned u = __builtin_bit_cast(unsigned, f); return (u + 0x7fffu + ((u >> 16) & 1u)) >> 16; }
__device__ __forceinline__ unsigned pk2(float lo, float hi) { return f2bf(lo) | (f2bf(hi) << 16); }
__device__ __forceinline__ float bf_lo(unsigned w) { return __builtin_bit_cast(float, w << 16); }
__device__ __forceinline__ float bf_hi(unsigned w) { return __builtin_bit_cast(float, w & 0xffff0000u); }
__device__ __forceinline__ u32x4 pack8f(f32x4 a, f32x4 b) { u32x4 w; w.x = cvt_pk_bf16(a[0], a[1]); w.y = cvt_pk_bf16(a[2], a[3]); w.z = cvt_pk_bf16(b[0], b[1]); w.w = cvt_pk_bf16(b[2], b[3]); return w; }
__device__ __forceinline__ int lane_id() { int l; asm volatile("v_mbcnt_lo_u32_b32 %0, -1, 0\n\tv_mbcnt_hi_u32_b32 %0, -1, %0" : "=v"(l)); return l; }
__device__ __forceinline__ float wave_sum(float v) {
#pragma unroll
    for (int o = 1; o < 64; o <<= 1) v += __shfl_xor(v, o);
    return v;
}
__device__ __forceinline__ float fast_exp(float x) { return __builtin_amdgcn_exp2f(x * 1.4426950408889634f); }
__device__ __forceinline__ float fast_sigmoid(float x) { return __builtin_amdgcn_rcpf(1.0f + fast_exp(-x)); }
__device__ __forceinline__ float gelu_tanh(float x) {
    const float a = 0.7978845608028654f * (x + 0.044715f * x * x * x);
    return x * fast_sigmoid(2.0f * a);
}

namespace pg8 {
constexpr int BM = 256, BK = 64, HALF = 128, HTB = HALF * BK * 2, STAGE_BYTES = 8 * HTB, NXCD = 8, WGM = 8;
__host__ __device__ __forceinline__ int lds_byte(int r, int c) { const int st = (r >> 4) * 2 + (c >> 5), rr = r & 15, cc = c & 31, ob = rr * 64 + cc * 2; return st * 1024 + (ob ^ (((ob >> 9) & 1) << 5)); }
__host__ __device__ __forceinline__ void stage_rc(int b, int& R, int& C) { const int st = b / 1024, sb = b % 1024, swz = sb ^ (((sb >> 9) & 1) << 5); R = (st >> 1) * 16 + swz / 64; C = (st & 1) * 32 + (swz % 64) / 2; }
__host__ __device__ __forceinline__ int perm32(int rho) { const int n = rho >> 4, i = rho & 15; return 8 * (i >> 2) + 4 * n + (i & 3); }

struct Unit { int pm, pn; };
struct Gemm { const bf16_t* A; const bf16_t* Bt; int lda, ldb, K; int kstepA = BK * 2; size_t tstepA = 0; int kstepB = BK * 2; size_t tstepB = 0; };

struct StaticOrder {
    int nM, nN, nwg, G, c;
    __host__ __device__ void init(int M, int N, int G_, int c_) { nM = M / BM; nN = N / BM; nwg = nM * nN; G = G_; c = c_; }
    __host__ __device__ bool next(int i, Unit& u) const {
        const long L = (long)i * G + c; if (L >= nwg) return false;
        int wgid = (int)L; { const int q = nwg / NXCD, r = nwg % NXCD, xcd = wgid % NXCD, off = wgid / NXCD; wgid = (xcd < r ? xcd * (q + 1) : r * (q + 1) + (xcd - r) * q) + off; }
        const int nig = WGM * nN, gid = wgid / nig, fm = gid * WGM, gsz = (nM - fm) < WGM ? (nM - fm) : WGM;
        u.pm = fm + ((wgid % nig) % gsz); u.pn = (wgid % nig) / gsz; return true;
    }
};
struct GroupOrder {
    int total, G, c;
    __host__ __device__ void init(int total_, int G_, int c_) { total = total_; G = G_; c = c_; }
    __host__ __device__ bool next(int i, Unit& u) const { const int L = i * G + c; if (L >= total) return false; u.pm = L; u.pn = L >> 2; return true; }
};

__device__ __forceinline__ float dpp_x1(float x) { return __builtin_bit_cast(float, __builtin_amdgcn_update_dpp(0, __builtin_bit_cast(int, x), 0xB1, 0xF, 0xF, false)); }
__device__ __forceinline__ f32x4 dpp_swap1(f32x4 v) { f32x4 r; r[0] = dpp_x1(v[0]); r[1] = dpp_x1(v[1]); r[2] = dpp_x1(v[2]); r[3] = dpp_x1(v[3]); return r; }
#define EPI_PIECES(...) \
    _Pragma("unroll") for (int ai = 0; ai < 2; ++ai) _Pragma("unroll") for (int m = 0; m < 4; ++m) { const int rl = ai * HALF + m * 16; \
        const f32x4 o0a = acc[ai][0][m][0], o0b = acc[ai][0][m][1], o1a = acc[ai][1][m][0], o1b = acc[ai][1][m][1]; \
        const f32x4 ra_ = dpp_swap1(odd ? o0a : o1a), rb_ = dpp_swap1(odd ? o0b : o1b); \
        const f32x4 p1a = odd ? ra_ : o0a, p1b = odd ? rb_ : o0b, p2a = odd ? o1a : ra_, p2b = odd ? o1b : rb_; __VA_ARGS__ \
        if (m & 1) asm volatile("" ::: "memory"); }
#define EPI_OPAQUE(x) asm volatile("" : "+v"(x))
struct EpiCtx { LAS unsigned char* lds; int tid, wid, lane; float pre; };

template <class Epi, class Sched, bool ALIGN_EPI>
__device__ __forceinline__ void gemm_phase(LAS unsigned char* lds, const Gemm g, const Sched& S, const Epi& E, const int wid) {
    const int lane = lane_id(), tid = wid * 64 + lane, wr = wid >> 2, wc = wid & 3, fr = lane & 15, fq = lane >> 4;
    const int K = g.K, nt = K / BK;
    unsigned voffA[2], voffB[2];
#pragma unroll
    for (int i = 0; i < 2; ++i) { int R, C; stage_rc(tid * 16 + i * 8192, R, C); const int Rb = (R >> 5) * 64 + perm32(R & 31);
        voffA[i] = (unsigned)(R * g.lda + C) * 2u; voffB[i] = (unsigned)(Rb * g.ldb + C) * 2u; }
    const size_t kstep = (size_t)g.kstepB, kstepA = (size_t)g.kstepA;
    const size_t hstepA = (size_t)HALF * g.lda * 2, hstepB = (size_t)32 * g.ldb * 2;
    const size_t tstepA = g.tstepA ? g.tstepA : 2 * hstepA, tstepB = g.tstepB ? g.tstepB : (size_t)BM * g.ldb * 2;
    const unsigned ldsw = (unsigned)wid * 1024u;
    const int aoff = lds_byte(wr * 64 + fr, fq * 8), boff = lds_byte(wc * 32 + fr, fq * 8);
#define PG8_SA(b, h) (((b) * 2 + (h)) * HTB)
#define PG8_SB(b, h) ((4 + (b) * 2 + (h)) * HTB)
#define PG8_STAGE(bufoff, gbase, voff) do { _Pragma("unroll") for (int _i = 0; _i < 2; ++_i) \
        __builtin_amdgcn_global_load_lds((const unsigned*)((const char*)(gbase) + (voff)[_i]), (LAS unsigned*)(lds + (bufoff) + ldsw + _i * 8192), 16, 0, 0); } while (0)
#define PG8_LDA(dst, b, h) do { _Pragma("unroll") for (int m = 0; m < 4; ++m) _Pragma("unroll") for (int k = 0; k < 2; ++k) dst[m][k] = *(const LAS bf16x8*)(lds + PG8_SA(b, h) + aoff + m * 2048 + k * 1024); } while (0)
#define PG8_LDB(dst, b, h) do { _Pragma("unroll") for (int n = 0; n < 2; ++n) _Pragma("unroll") for (int k = 0; k < 2; ++k) dst[n][k] = *(const LAS bf16x8*)(lds + PG8_SB(b, h) + boff + n * 2048 + k * 1024); } while (0)
#define PG8_MMA(ai, bj, At, Bt) do { __builtin_amdgcn_s_setprio(1); _Pragma("unroll") for (int m = 0; m < 4; ++m) _Pragma("unroll") for (int n = 0; n < 2; ++n) _Pragma("unroll") for (int k = 0; k < 2; ++k) \
        acc[ai][bj][m][n] = __builtin_amdgcn_mfma_f32_16x16x32_bf16(Bt[n][k], At[m][k], acc[ai][bj][m][n], 0, 0, 0); __builtin_amdgcn_s_setprio(0); } while (0)
#define PG8_WAIT_V(n) asm volatile("s_waitcnt vmcnt(" #n ")" ::: "memory")
#define PG8_WAIT_L(n) asm volatile("s_waitcnt lgkmcnt(" #n ")" ::: "memory")
#define PG8_BAR __builtin_amdgcn_s_barrier()
#define PG8_SCHED __builtin_amdgcn_sched_barrier(0)
    Unit cur, nxt; int ui = 0;
    if (!S.next(0, cur)) return;
    EpiCtx X; X.lds = lds; X.tid = tid; X.wid = wid; X.lane = lane; X.pre = 0.f;
    f32x4 acc[2][2][4][2];
#pragma unroll
    for (int a = 0; a < 2; ++a)
#pragma unroll
        for (int b = 0; b < 2; ++b)
#pragma unroll
            for (int m = 0; m < 4; ++m)
#pragma unroll
                for (int n = 0; n < 2; ++n) acc[a][b][m][n] = (f32x4){0.f, 0.f, 0.f, 0.f};
    bf16x8 At[4][2], B0[2][2], B1[2][2];
    const char* cA = (const char*)g.A + (size_t)cur.pm * tstepA; const char* cB = (const char*)g.Bt + (size_t)cur.pn * tstepB;
    PG8_STAGE(PG8_SB(0, 0), cB, voffB); PG8_STAGE(PG8_SB(0, 1), cB + hstepB, voffB); PG8_STAGE(PG8_SA(0, 0), cA, voffA); PG8_STAGE(PG8_SA(0, 1), cA + hstepA, voffA);
    if (wr == 1) PG8_BAR;
    PG8_WAIT_V(2); PG8_BAR;
    PG8_STAGE(PG8_SB(1, 0), cB + kstep, voffB); PG8_STAGE(PG8_SA(1, 0), cA + kstepA, voffA); PG8_STAGE(PG8_SB(1, 1), cB + hstepB + kstep, voffB);
    PG8_WAIT_V(6); PG8_BAR;
    for (;;) {
        const bool has_next = S.next(ui + 1, nxt);
        const char* nA = has_next ? (const char*)g.A + (size_t)nxt.pm * tstepA : cA; const char* nB = has_next ? (const char*)g.Bt + (size_t)nxt.pn * tstepB : cB;
#pragma nounroll
        for (int t = 0; t < nt; t += 2) {
            const bool last = (t == nt - 2);
            if constexpr (Epi::HAS_PRE) { if (last) X.pre = E.pre(cur, tid); }
            const char* a1 = cA + (size_t)(t + 1) * kstepA;
            const char* a2 = last ? nA : cA + (size_t)(t + 2) * kstepA; const char* b2 = last ? nB : cB + (size_t)(t + 2) * kstep;
            const char* a3 = a2 + kstepA; const char* b3 = b2 + kstep;
            PG8_LDB(B0, 0, 0); PG8_LDB(B1, 0, 1); PG8_SCHED; PG8_LDA(At, 0, 0); PG8_STAGE(PG8_SA(1, 1), a1 + hstepA, voffA);
            PG8_WAIT_V(8); PG8_WAIT_L(0); PG8_BAR; PG8_MMA(0, 0, At, B0); PG8_MMA(0, 1, At, B1); PG8_BAR; PG8_SCHED;
            PG8_LDA(At, 0, 1); PG8_STAGE(PG8_SB(0, 0), b2, voffB); PG8_STAGE(PG8_SB(0, 1), b2 + hstepB, voffB); PG8_STAGE(PG8_SA(0, 0), a2, voffA);
            PG8_WAIT_V(8); PG8_WAIT_L(0); PG8_BAR; PG8_MMA(1, 0, At, B0); PG8_MMA(1, 1, At, B1); PG8_BAR; PG8_SCHED;
            PG8_LDB(B0, 1, 0); PG8_LDB(B1, 1, 1); PG8_SCHED; PG8_LDA(At, 1, 0); PG8_STAGE(PG8_SA(0, 1), a2 + hstepA, voffA);
            PG8_WAIT_V(8); PG8_WAIT_L(0); PG8_BAR; PG8_MMA(0, 0, At, B0); PG8_MMA(0, 1, At, B1); PG8_BAR; PG8_SCHED;
            PG8_LDA(At, 1, 1); PG8_STAGE(PG8_SB(1, 0), b3, voffB); PG8_STAGE(PG8_SB(1, 1), b3 + hstepB, voffB); PG8_STAGE(PG8_SA(1, 0), a3, voffA);
            PG8_WAIT_V(8); PG8_WAIT_L(0); PG8_BAR; PG8_MMA(1, 0, At, B0); PG8_MMA(1, 1, At, B1); PG8_BAR; PG8_SCHED;
        }
        if constexpr (ALIGN_EPI) { if (wr == 0) PG8_BAR; }
        E(acc, cur, wr, wc, fr, fq, X);
        if (!has_next) break;
#pragma unroll
        for (int a = 0; a < 2; ++a)
#pragma unroll
            for (int b = 0; b < 2; ++b)
#pragma unroll
                for (int m = 0; m < 4; ++m)
#pragma unroll
                    for (int n = 0; n < 2; ++n) acc[a][b][m][n] = (f32x4){0.f, 0.f, 0.f, 0.f};
        cur = nxt; cA = nA; cB = nB; ++ui;
        if constexpr (ALIGN_EPI) { if (wr == 1) PG8_BAR; }
    }
    PG8_WAIT_V(0);
    if constexpr (!ALIGN_EPI) { if (wr == 0) PG8_BAR; }
    PG8_BAR;
#undef PG8_SA
#undef PG8_SB
#undef PG8_STAGE
#undef PG8_LDA
#undef PG8_LDB
#undef PG8_MMA
#undef PG8_WAIT_V
#undef PG8_WAIT_L
#undef PG8_BAR
#undef PG8_SCHED
}

struct EpiIn0 {
    static constexpr bool HAS_PRE = false;
    bf16_t* UA; bf16_t* QKV;
    __device__ __forceinline__ void operator()(const f32x4 (&acc)[2][2][4][2], const Unit& u, int wr, int wc, int fr, int fq, const EpiCtx& X) const {
        const bool odd = fr & 1; const int fe = fr - (fr & 1), o32 = (fr & 1) * 32;
        if (u.pn < 8) {
            char* base = (char*)(UA + ((size_t)u.pn * 16 * 1024 + (size_t)u.pm * 16) * UA_LD);
            unsigned lo = (unsigned)(((wc * 4 + (fr & 1) * 2 + (fq >> 1)) * 1024 + wr * 4) * UA_LD + fe * 16 + 8 * (fq & 1)) * 2u; EPI_OPAQUE(lo);
            EPI_PIECES({ const unsigned off = lo + (unsigned)((rl >> 4) * UA_LD) * 2u; *(u32x4*)(base + off) = pack8f(p1a, p1b); *(u32x4*)(base + off + 32) = pack8f(p2a, p2b); })
        } else {
            char* base = (char*)(QKV + (size_t)u.pm * BM * QKV0_LD + (u.pn * BM - W_SSM));
            unsigned lo = (unsigned)((wr * 64 + fe) * QKV0_LD + wc * 64 + o32 + 8 * fq) * 2u; EPI_OPAQUE(lo);
            EPI_PIECES({ const unsigned off = lo + (unsigned)(rl * QKV0_LD) * 2u; *(u32x4*)(base + off) = pack8f(p1a, p1b); *(u32x4*)(base + off + QKV0_LD * 2) = pack8f(p2a, p2b); })
        }
    }
};
struct EpiS1 {
    static constexpr bool HAS_PRE = false;
    float* XLOC;
    __device__ __forceinline__ void operator()(const f32x4 (&acc)[2][2][4][2], const Unit& u, int wr, int wc, int fr, int fq, const EpiCtx& X) const {
        const bool odd = fr & 1; const int fe = fr - (fr & 1), o32 = (fr & 1) * 32;
        char* base = (char*)(XLOC + (size_t)u.pm * BM * 128);
        unsigned lo = (unsigned)((wr * 64 + fe) * 128 + wc * 64 + o32 + 8 * fq) * 4u; EPI_OPAQUE(lo);
        EPI_PIECES({ if (wc < 2) { float* p = (float*)(base + (lo + (unsigned)(rl * 128) * 4u)); *(f32x4*)p = p1a; *(f32x4*)(p + 4) = p1b; *(f32x4*)(p + 128) = p2a; *(f32x4*)(p + 132) = p2b; } })
    }
};
struct EpiS2 {
    static constexpr bool HAS_PRE = false;
    const bf16_t* UA; const float* dvec; bf16_t* GACT;
    __device__ __forceinline__ void operator()(const f32x4 (&acc)[2][2][4][2], const Unit& u, int wr, int wc, int fr, int fq, const EpiCtx& X) const {
        const bool odd = fr & 1; const int fe = fr - (fr & 1), o32 = (fr & 1) * 32;
        const int g = u.pn; const int p0 = 8 * (fq & 1);
        const f32x4 d0 = *(const f32x4*)(dvec + g * 16 + p0), d1 = *(const f32x4*)(dvec + g * 16 + p0 + 4);
        const char* ub = (const char*)(UA + (size_t)u.pm * BM * UA_LD);
        unsigned ulo = (unsigned)((wr * 64 + fe) * UA_LD + wc * 64 + o32 + 8 * fq) * 2u; EPI_OPAQUE(ulo);
        char* gb = (char*)(GACT + (size_t)(u.pm & 3) * 256 * 16 * W_SSM + g * 16);
        unsigned glo = (unsigned)(((wr * 64 + fe) * 16 + wc * 4 + (fr & 1) * 2 + (fq >> 1)) * W_SSM + p0) * 2u; EPI_OPAQUE(glo);
#define S2_ONE(pa, pb, uoff, goff) do { const u32x4 uu = *(const u32x4*)(ub + (uoff)); f32x4 a, b; \
            a[0] = gelu_tanh(pa[0] + d0[0] * bf_lo(uu.x)); a[1] = gelu_tanh(pa[1] + d0[1] * bf_hi(uu.x)); a[2] = gelu_tanh(pa[2] + d0[2] * bf_lo(uu.y)); a[3] = gelu_tanh(pa[3] + d0[3] * bf_hi(uu.y)); \
            b[0] = gelu_tanh(pb[0] + d1[0] * bf_lo(uu.z)); b[1] = gelu_tanh(pb[1] + d1[1] * bf_hi(uu.z)); b[2] = gelu_tanh(pb[2] + d1[2] * bf_lo(uu.w)); b[3] = gelu_tanh(pb[3] + d1[3] * bf_hi(uu.w)); \
            *(u32x4*)(gb + (goff)) = pack8f(a, b); } while (0)
        EPI_PIECES({ const unsigned uoff = ulo + (unsigned)(rl * UA_LD) * 2u, goff = glo + (unsigned)(rl * 16 * W_SSM) * 2u;
            S2_ONE(p1a, p1b, uoff, goff); S2_ONE(p2a, p2b, uoff + UA_LD * 2, goff + 16 * W_SSM * 2); })
#undef S2_ONE
    }
};
struct EpiGlu {
    static constexpr bool HAS_PRE = false;
    const bf16_t* GACT; bf16_t* CC;
    __device__ __forceinline__ void operator()(const f32x4 (&acc)[2][2][4][2], const Unit& u, int wr, int wc, int fr, int fq, const EpiCtx& X) const {
        const bool odd = fr & 1; const int fe = fr - (fr & 1), o32 = (fr & 1) * 32;
        const char* gb = (const char*)(GACT + (size_t)u.pm * BM * W_SSM + u.pn * BM);
        unsigned glo = (unsigned)((wr * 64 + fe) * W_SSM + wc * 64 + o32 + 8 * fq) * 2u; EPI_OPAQUE(glo);
        char* cb = (char*)(CC + (size_t)u.pm * BM * DM + u.pn * BM);
        unsigned clo = (unsigned)((wr * 64 + fe) * DM + wc * 64 + o32 + 8 * fq) * 2u; EPI_OPAQUE(clo);
#define GLU_ONE(pa, pb, goff, coff) do { const u32x4 gg = *(const u32x4*)(gb + (goff)); f32x4 a, b; \
            a[0] = bf_lo(gg.x) * fast_sigmoid(pa[0]); a[1] = bf_hi(gg.x) * fast_sigmoid(pa[1]); a[2] = bf_lo(gg.y) * fast_sigmoid(pa[2]); a[3] = bf_hi(gg.y) * fast_sigmoid(pa[3]); \
            b[0] = bf_lo(gg.z) * fast_sigmoid(pb[0]); b[1] = bf_hi(gg.z) * fast_sigmoid(pb[1]); b[2] = bf_lo(gg.w) * fast_sigmoid(pb[2]); b[3] = bf_hi(gg.w) * fast_sigmoid(pb[3]); \
            *(u32x4*)(cb + (coff)) = pack8f(a, b); } while (0)
        EPI_PIECES({ const unsigned goff = glo + (unsigned)(rl * W_SSM) * 2u, coff = clo + (unsigned)(rl * DM) * 2u;
            GLU_ONE(p1a, p1b, goff, coff); GLU_ONE(p2a, p2b, goff + W_SSM * 2, coff + DM * 2); })
#undef GLU_ONE
    }
};
__device__ __forceinline__ void build_tbl(const f32x2* PS, int pm, LAS unsigned char* lds, int wid, int lane) {
    LAS f32x2* tbl = (LAS f32x2*)(lds + TBL_OFF);
    const f32x2* p = PS + ((size_t)pm * BM + wid * 32) * 64 + lane;
#pragma unroll 8
    for (int i = 0; i < 32; ++i) {
        const f32x2 v = p[(size_t)i * 64];
        const float a = wave_sum(v.x), b = wave_sum(v.y);
        if (lane == 0) { const float mu = a * (1.f / DM), var = fmaxf(b * (1.f / DM) - mu * mu, 0.f); tbl[wid * 32 + i] = (f32x2){mu, 1.f / sqrtf(var + LN_EPS)}; }
    }
}
__device__ __forceinline__ void ensure_tbl(const f32x2* PS, int sid, int pm, const EpiCtx& X) {
    volatile LAS unsigned* keyw = (volatile LAS unsigned*)(X.lds + MISC_OFF) + KEY_WORD;
    const unsigned key = (unsigned)(sid * 64 + pm + 1);
    if ((unsigned)__builtin_amdgcn_readfirstlane((int)keyw[0]) != key) {
        build_tbl(PS, pm, X.lds, X.wid, X.lane);
        asm volatile("s_waitcnt lgkmcnt(0)" ::: "memory"); __builtin_amdgcn_s_barrier(); asm volatile("" ::: "memory");
        if (X.tid == 0) keyw[0] = key;
    }
}
template <int RESM, bool OUTF> struct EpiResLN {
    static constexpr bool HAS_PRE = false;
    static constexpr bool RESN = RESM == 1;
    static_assert(RESM == 1 || RESM == 2, "the residual is always read from XB (bf16)");
    const float* res32; bf16_t* XB; float* Y32;
    const f32x2* PSp; int sidp; const float* gp; const float* bp;
    f32x2* PSn;
    __device__ __forceinline__ void operator()(const f32x4 (&acc)[2][2][4][2], const Unit& u, int wr, int wc, int fr, int fq, const EpiCtx& X) const {
        const bool odd = fr & 1; const int fe = fr - (fr & 1), o32 = (fr & 1) * 32;
        static_assert(!OUTF, "XB is K-tile-blocked; the f32 output path is not used");
        char* yb = nullptr; char* xb = (char*)(XB + (size_t)u.pm * BM * DM + (size_t)(u.pn * 4 + wc) * (BM * 64));
        unsigned lo = (unsigned)((wr * 64 + fe) * 64 + o32 + 8 * fq) * 2u; EPI_OPAQUE(lo);
        const int col = u.pn * BM + wc * 64 + o32 + 8 * fq;
        f32x4 g0, g1, b0, b1;
        if (RESN) { ensure_tbl(PSp, sidp, u.pm, X);
            g0 = *(const f32x4*)(gp + col); g1 = *(const f32x4*)(gp + col + 4); b0 = *(const f32x4*)(bp + col) * ALPHA; b1 = *(const f32x4*)(bp + col + 4) * ALPHA; }
        const LAS f32x2* tbl = (const LAS f32x2*)(X.lds + TBL_OFF) + wr * 64 + fe;
        f32x2* ps = PSn + ((size_t)u.pm * BM + wr * 64 + fe) * 64 + u.pn * 4 + wc;
#pragma unroll
        for (int ai = 0; ai < 2; ++ai) {
            u32x4 raw[8];
#pragma unroll
            for (int m = 0; m < 4; ++m) { const unsigned off = lo + (unsigned)((ai * HALF + m * 16) * 64) * 2u; raw[2 * m] = *(const u32x4*)(xb + off); raw[2 * m + 1] = *(const u32x4*)(xb + off + 128); }
#pragma unroll
            for (int m = 0; m < 4; ++m) {
                const int rl = ai * HALF + m * 16; const unsigned off = lo + (unsigned)(rl * 64) * 2u;
                const f32x4 o0a = acc[ai][0][m][0], o0b = acc[ai][0][m][1], o1a = acc[ai][1][m][0], o1b = acc[ai][1][m][1];
                const f32x4 ra_ = dpp_swap1(odd ? o0a : o1a), rb_ = dpp_swap1(odd ? o0b : o1b);
                const f32x4 pa[2] = {odd ? ra_ : o0a, odd ? o1a : ra_}, pb[2] = {odd ? rb_ : o0b, odd ? o1b : rb_};
#pragma unroll
                for (int q = 0; q < 2; ++q) {
                    const u32x4 w0 = raw[2 * m + q];
                    const f32x4 r0 = (f32x4){bf_lo(w0.x), bf_hi(w0.x), bf_lo(w0.y), bf_hi(w0.y)}, r1 = (f32x4){bf_lo(w0.z), bf_hi(w0.z), bf_lo(w0.w), bf_hi(w0.w)};
                    f32x4 y0, y1;
                    if (RESN) { const f32x2 t = tbl[rl + q]; const float mu = t.x, ra = t.y * ALPHA; y0 = (r0 - mu) * ra * g0 + b0 + pa[q]; y1 = (r1 - mu) * ra * g1 + b1 + pb[q]; }
                    else { y0 = r0 * ALPHA + pa[q]; y1 = r1 * ALPHA + pb[q]; }
                    { const u32x4 w = pack8f(y0, y1); *(u32x4*)(xb + off + q * 128) = w;
                        y0 = (f32x4){bf_lo(w.x), bf_hi(w.x), bf_lo(w.y), bf_hi(w.y)}; y1 = (f32x4){bf_lo(w.z), bf_hi(w.z), bf_lo(w.w), bf_hi(w.w)}; }
                    float sa = ((y0[0] + y0[1]) + (y0[2] + y0[3])) + ((y1[0] + y1[1]) + (y1[2] + y1[3]));
                    float sb = ((y0[0] * y0[0] + y0[1] * y0[1]) + (y0[2] * y0[2] + y0[3] * y0[3])) + ((y1[0] * y1[0] + y1[1] * y1[1]) + (y1[2] * y1[2] + y1[3] * y1[3]));
                    sa += dpp_x1(sa);
                    sb += dpp_x1(sb);
                    sa += __shfl_xor(sa, 16); sa += __shfl_xor(sa, 32); sb += __shfl_xor(sb, 16); sb += __shfl_xor(sb, 32);
                    if (fq == 0 && !odd) ps[(size_t)(rl + q) * 64] = (f32x2){sa, sb};
                }
            }
            asm volatile("" ::: "memory");
        }
    }
};
template <int ACT, int LDC, bool BLK = false> struct EpiLN {
    static constexpr bool HAS_PRE = true;
    bf16_t* O; const f32x2* PS; int sid; const float* sv; const float* tv;
    __device__ __forceinline__ float pre(const Unit& u, int tid) const { return (tid < 256 ? sv : tv)[u.pn * BM + (tid & 255)]; }
    __device__ __forceinline__ void operator()(const f32x4 (&acc)[2][2][4][2], const Unit& u, int wr, int wc, int fr, int fq, const EpiCtx& X) const {
        ensure_tbl(PS, sid, u.pm, X);
        LAS float* stb = (LAS float*)(X.lds + STB_OFF);
        stb[X.tid] = X.pre;
        asm volatile("s_waitcnt lgkmcnt(0)" ::: "memory"); __builtin_amdgcn_s_barrier(); asm volatile("" ::: "memory");
        const bool odd = fr & 1; const int fe = fr - (fr & 1), o32 = (fr & 1) * 32;
        constexpr int RP = BLK ? 64 : LDC;
        char* base = BLK ? (char*)(O + (size_t)u.pm * BM * LDC + (size_t)(u.pn * 4 + wc) * (BM * 64)) : (char*)(O + (size_t)u.pm * BM * LDC + u.pn * BM);
        unsigned lo = (unsigned)((wr * 64 + fe) * RP + (BLK ? 0 : wc * 64) + o32 + 8 * fq) * 2u; EPI_OPAQUE(lo);
        const LAS f32x2* tbl = (const LAS f32x2*)(X.lds + TBL_OFF) + wr * 64 + fe;
        const LAS f32x4* sp = (const LAS f32x4*)(stb + wc * 64 + o32 + 8 * fq);
        const f32x4 sa = sp[0], sb = sp[1], ta = sp[64], tb = sp[65];
#define LN_ONE(pa, pb, row_, off_) do { const f32x2 t = tbl[row_]; f32x4 a = ((pa) - sa * t.x) * t.y + ta, b = ((pb) - sb * t.x) * t.y + tb; \
            if (ACT == 1) { _Pragma("unroll") for (int e = 0; e < 4; ++e) { const float x = fmaxf(a[e], 0.f), y = fmaxf(b[e], 0.f); a[e] = x * x; b[e] = y * y; } } \
            if (BLK) __builtin_nontemporal_store(pack8f(a, b), (u32x4*)(base + (off_))); else *(u32x4*)(base + (off_)) = pack8f(a, b); } while (0)
        EPI_PIECES({ const unsigned off = lo + (unsigned)(rl * RP) * 2u; LN_ONE(p1a, p1b, rl, off); LN_ONE(p2a, p2b, rl + 1, off + RP * 2); })
#undef LN_ONE
    }
};
struct EpiIn1LN {
    static constexpr bool HAS_PRE = true;
    bf16_t* QKV; float* FLOGT; const f32x2* PS; int sid; const float* sv; const float* tv;
    __device__ __forceinline__ float pre(const Unit& u, int tid) const { return (tid < 256 ? sv : tv)[u.pn * BM + (tid & 255)]; }
    __device__ __forceinline__ void operator()(const f32x4 (&acc)[2][2][4][2], const Unit& u, int wr, int wc, int fr, int fq, const EpiCtx& X) const {
        if (u.pn < 48) { const EpiLN<0, QKV1_LD> E{QKV, PS, sid, sv, tv}; E(acc, u, wr, wc, fr, fq, X); }
        else {
            ensure_tbl(PS, sid, u.pm, X);
            LAS float* stb = (LAS float*)(X.lds + STB_OFF);
            stb[X.tid] = X.pre;
            asm volatile("s_waitcnt lgkmcnt(0)" ::: "memory"); __builtin_amdgcn_s_barrier(); asm volatile("" ::: "memory");
            if (wc == 0) {
                const int row0 = u.pm * BM + wr * 64 + fr;
                const LAS f32x2* tbl = (const LAS f32x2*)(X.lds + TBL_OFF) + wr * 64 + fr;
                const LAS f32x4* sp = (const LAS f32x4*)(stb + 8 * fq);
                const f32x4 sa = sp[0], sb = sp[1], ta = sp[64], tb = sp[65];
#pragma unroll
                for (int ai = 0; ai < 2; ++ai)
#pragma unroll
                    for (int m = 0; m < 4; ++m) {
                        const int row = row0 + ai * HALF + m * 16; const f32x2 t = tbl[ai * HALF + m * 16];
                        const f32x4 a = (acc[ai][0][m][0] - sa * t.x) * t.y + ta, b = (acc[ai][0][m][1] - sb * t.x) * t.y + tb;
                        float* d = FLOGT + ((size_t)(row >> 12) * FOX_H + 8 * fq) * SEQ + (row & (SEQ - 1));
#pragma unroll
                        for (int e = 0; e < 4; ++e) { d[(size_t)e * SEQ] = a[e]; d[(size_t)(4 + e) * SEQ] = b[e]; }
                    }
            }
        }
    }
};
}

namespace att {
constexpr int D = 128, NW = 8, QBLK = 32, KVBLK = 64, QB = 256;
constexpr int SHM_V = KVBLK * D * 2, SHM_K = KVBLK * D * 2;
constexpr int OFF_WS = 2 * SHM_V + 2 * SHM_K;
constexpr int OFF_FLAG = OFF_WS + NW * 64 * 4;
constexpr int OFF_CB = OFF_FLAG + 64;
constexpr int OFF_QL = OFF_CB + 4096 * 4;
constexpr int ATT_LDS = OFF_QL + 8 * 4 * 1024;
static_assert(ATT_LDS <= RING_BYTES, "attention LDS");
#define KSWZ(row, colB) ((row) * 256 + ((colB) ^ (((row) & 7) << 4)))
#define SBAR() __builtin_amdgcn_sched_barrier(0)
__device__ __forceinline__ int v_st(int k, int c) { const int kk = (k & ~0xC) | ((k & 4) << 1) | ((k & 8) >> 1); return ((kk >> 3) * 4 + (c >> 5)) * 512 + ((kk & 7) * 32 + (c & 31)) * 2; }
__device__ __forceinline__ int v_rd_base(int lane) { return ((lane & 3) << 3) | (((lane >> 2) & 3) << 6) | (((lane >> 4) & 1) << 5) | (((lane >> 5) & 1) << 8); }
constexpr int v_rd_off(int d0, int ks, int half) { return d0 * 512 + ks * 4096 + half * 2048; }
__device__ __forceinline__ int crow(int r, int hi) { return (r & 3) + 8 * (r >> 2) + 4 * hi; }
__device__ __forceinline__ bf16x8 load8(const bf16_t* p) { return *reinterpret_cast<const bf16x8*>(p); }

__device__ __forceinline__ void mask_tile(f32x16& p0, f32x16& p1, int dq, unsigned W) {
    const float NEG = -__builtin_inff();
#pragma unroll
    for (int r = 0; r < 16; ++r) {
        const int c = (r & 3) + 8 * (r >> 2);
        if ((unsigned)(dq - c) >= W) p0[r] = NEG;
        if ((unsigned)(dq - c - 32) >= W) p1[r] = NEG;
    }
}
constexpr float THR = 8.f;
__device__ __forceinline__ void partialSM(f32x16& p0, f32x16& p1, float& m_reg, float& mn, float& alpha) {
    float pmax = p0[0];
#pragma unroll
    for (int r = 1; r < 16; ++r) pmax = fmaxf(pmax, p0[r]);
#pragma unroll
    for (int r = 0; r < 16; ++r) pmax = fmaxf(pmax, p1[r]);
    { auto rr = __builtin_amdgcn_permlane32_swap(__float_as_uint(pmax), __float_as_uint(pmax), false, false);
      pmax = fmaxf(__uint_as_float(rr[0]), __uint_as_float(rr[1])); }
    constexpr float C2 = 1.4426950408889634f * ATT_SCALE;
    if (__builtin_expect(__all((pmax - m_reg) * ATT_SCALE <= THR), 1)) { mn = m_reg; alpha = 1.f; }
    else { mn = fmaxf(m_reg, pmax); alpha = __builtin_amdgcn_exp2f((m_reg - mn) * C2); m_reg = mn; }
    const float mnL = -mn * C2;
#pragma unroll
    for (int r = 0; r < 16; ++r) p0[r] = fmaf(p0[r], C2, mnL);
#pragma unroll
    for (int r = 0; r < 16; ++r) p1[r] = fmaf(p1[r], C2, mnL);
#pragma unroll
    for (int r = 0; r < 16; ++r) p0[r] = __builtin_amdgcn_exp2f(p0[r]);
}
#define PK4(P, B_, OUT) do { unsigned a0 = cvt_pk_bf16(P[B_+0], P[B_+1]), a1 = cvt_pk_bf16(P[B_+2], P[B_+3]);                          \
        unsigned b0 = cvt_pk_bf16(P[B_+4], P[B_+5]), b1 = cvt_pk_bf16(P[B_+6], P[B_+7]);                                             \
        auto r0 = __builtin_amdgcn_permlane32_swap(a0, b0, false, false); auto r1 = __builtin_amdgcn_permlane32_swap(a1, b1, false, false); \
        u32x4 w = {r0[0], r1[0], r0[1], r1[1]}; OUT = *reinterpret_cast<bf16x8*>(&w); } while (0)
__device__ __forceinline__ void finishSM(f32x16& p0, f32x16& p1, float alpha, float& l_reg, bf16x8& pa0, bf16x8& pa1, bf16x8& pa2, bf16x8& pa3) {
#pragma unroll
    for (int r = 0; r < 16; ++r) p1[r] = __builtin_amdgcn_exp2f(p1[r]);
    float ps = 0;
#pragma unroll
    for (int r = 0; r < 16; ++r) ps += p0[r];
#pragma unroll
    for (int r = 0; r < 16; ++r) ps += p1[r];
    { auto rr = __builtin_amdgcn_permlane32_swap(__float_as_uint(ps), __float_as_uint(ps), false, false);
      ps = __uint_as_float(rr[0]) + __uint_as_float(rr[1]); }
    l_reg = l_reg * alpha + ps;
    PK4(p0, 0, pa0); PK4(p0, 8, pa1); PK4(p1, 0, pa2); PK4(p1, 8, pa3);
}
template <int KB, bool BIAS, int QL = 0>
__device__ __forceinline__ void qkt(f32x16& p0, f32x16& p1, const char* K_lds, int r32, int hi, const bf16x8* qr, const float* cbt, const char* qlds = nullptr) {
    if constexpr (BIAS) {
#pragma unroll
        for (int g = 0; g < 4; ++g) { const f32x4 a = *(const f32x4*)(cbt + 8 * g), b = *(const f32x4*)(cbt + 32 + 8 * g);
#pragma unroll
            for (int e = 0; e < 4; ++e) { p0[4 * g + e] = a[e]; p1[4 * g + e] = b[e]; } }
    } else { p0 = f32x16{}; p1 = f32x16{}; }
    const char* kb[4];
#pragma unroll
    for (int dd = 0; dd < 4; ++dd) kb[dd] = K_lds + KB * SHM_K + KSWZ(r32, (dd * 16 + hi * 8) * 2);
#pragma unroll
    for (int d0 = 0; d0 < 8; ++d0) { const char* a = kb[d0 & 3] + (d0 >> 2) * 128;
        bf16x8 b0 = *reinterpret_cast<const bf16x8*>(a);
        bf16x8 b1 = *reinterpret_cast<const bf16x8*>(a + 32 * 256);
        bf16x8 q; if (d0 < 8 - QL) q = qr[d0]; else q = *reinterpret_cast<const bf16x8*>(qlds + (d0 - (8 - QL)) * 1024);
        p0 = __builtin_amdgcn_mfma_f32_32x32x16_bf16(b0, q, p0, 0, 0, 0);
        p1 = __builtin_amdgcn_mfma_f32_32x32x16_bf16(b1, q, p1, 0, 0, 0); }
}
template <int VB>
__device__ __forceinline__ void pv_tile(f32x16* o, int vb0, bf16x8 pa0, bf16x8 pa1, bf16x8 pa2, bf16x8 pa3) {
#define TRRD(dst, off) asm volatile("ds_read_b64_tr_b16 %0, %1 offset:%2" : "=&v"(dst) : "v"(vb0), "i"(off) : "memory")
#define PV_D0(d0) do { s16x4 l0, l1, l2, l3, h0, h1, h2, h3; constexpr int b_ = VB * SHM_V + v_rd_off(d0, 0, 0); \
        TRRD(l0, b_); TRRD(h0, b_ + 2048); TRRD(l1, b_ + 4096); TRRD(h1, b_ + 6144); TRRD(l2, b_ + 8192); TRRD(h2, b_ + 10240); TRRD(l3, b_ + 12288); TRRD(h3, b_ + 14336); \
        asm volatile("s_waitcnt lgkmcnt(0)" ::: "memory"); SBAR();   \
        o[d0] = __builtin_amdgcn_mfma_f32_32x32x16_bf16(pa0, (bf16x8){l0[0], l0[1], l0[2], l0[3], h0[0], h0[1], h0[2], h0[3]}, o[d0], 0, 0, 0);   \
        o[d0] = __builtin_amdgcn_mfma_f32_32x32x16_bf16(pa1, (bf16x8){l1[0], l1[1], l1[2], l1[3], h1[0], h1[1], h1[2], h1[3]}, o[d0], 0, 0, 0);   \
        o[d0] = __builtin_amdgcn_mfma_f32_32x32x16_bf16(pa2, (bf16x8){l2[0], l2[1], l2[2], l2[3], h2[0], h2[1], h2[2], h2[3]}, o[d0], 0, 0, 0);   \
        o[d0] = __builtin_amdgcn_mfma_f32_32x32x16_bf16(pa3, (bf16x8){l3[0], l3[1], l3[2], l3[3], h3[0], h3[1], h3[2], h3[3]}, o[d0], 0, 0, 0); } while (0)
    PV_D0(0); PV_D0(1); PV_D0(2); PV_D0(3);
#undef PV_D0
#undef TRRD
}

struct BlockRef { const bf16_t* Q; const bf16_t* K; const bf16_t* V; bf16_t* O; const float* CB; int P0; int bh; int jlo; };
struct Seam { bf16x8 qr[8]; bf16x8 st_v0, st_v1, st_k0, st_k1; };
constexpr int LDQ = QKV1_LD, LDO = DM;
#define GLD8(base, off32) (*(const bf16x8*)((const char*)(base) + (unsigned)(off32)))
#define VMW() asm volatile("s_waitcnt vmcnt(0)" ::: "memory")
#define VMWN(n) asm volatile("s_waitcnt vmcnt(%0)" :: "i"(n) : "memory")
#define SLOAD_H(Kp, Vp, k0) do { const char* kb__ = (const char*)(Kp) + (size_t)(k0) * (LDQ * 2); const char* vb__ = (const char*)(Vp) + (size_t)(k0) * (LDQ * 2); \
                         S.st_v0 = GLD8(vb__, loff); S.st_v1 = GLD8(vb__, loff + 32u * LDQ * 2u);              \
                         S.st_k0 = GLD8(kb__, loff); S.st_k1 = GLD8(kb__, loff + 32u * LDQ * 2u); } while (0)
#define SWRITE_HK(bf) do { *(bf16x8*)(K_lds + (bf) * SHM_K + kws) = S.st_k0; *(bf16x8*)(K_lds + (bf) * SHM_K + kws + 32 * 256) = S.st_k1; } while (0)
#define SWRITE_HV(bf) do { *(bf16x8*)(V_lds + (bf) * SHM_V + vst0) = S.st_v0; *(bf16x8*)(V_lds + (bf) * SHM_V + vst1) = S.st_v1; } while (0)
#define SWRITE_H(bf) do { SWRITE_HV(bf); SWRITE_HK(bf); } while (0)
__device__ __forceinline__ bool fox_item(int bx, int k, int G, int total, int& bh, int& y) {
    if (G == 256) { if (k >= 4) return false; const int x = bx & 7, c = bx >> 3, i = c & 7, sft = 4 * ((k + (i >> 1)) & 3);
        bh = 16 * x + (c >> 3) + 4 * k; y = ((i & 1) ? (0x6521 >> sft) : (0x7430 >> sft)) & 0xf; return true; }
    const int L = bx + k * G; if (L >= total) return false; bh = L >> 3; y = L & 7; return true;
}
__device__ __forceinline__ BlockRef fox_ref(int bh, int y, int pass, const bf16_t* QKV1, bf16_t* ATT, const float* CB, int jlo) {
    const int qb = pass ? 15 - y : y, b = bh >> 5, h = bh & 31;
    BlockRef r; const size_t tok0 = (size_t)b * SEQ;
    r.Q = QKV1 + (tok0 + qb * 256) * QKV1_LD + h * HD; r.K = QKV1 + tok0 * QKV1_LD + 4096 + h * HD; r.V = QKV1 + tok0 * QKV1_LD + 8192 + h * HD;
    r.O = ATT + (tok0 + qb * 256) * DM + h * HD; r.CB = CB + (size_t)bh * SEQ; r.P0 = qb * 256; r.bh = bh; r.jlo = jlo; return r;
}
__device__ __forceinline__ void fox_prime(const BlockRef& cur, char* lds, Seam& S, const int wid) {
    const int lane = lane_id(), tid = wid * 64 + lane, r32 = lane & 31, hi = lane >> 5;
    const int sr = tid >> 4, sc = (tid & 15) * 8, kws = KSWZ(sr, sc * 2); char* K_lds = lds + 2 * SHM_V;
    const unsigned loff = (unsigned)(sr * LDQ + sc) * 2u, qoff = (unsigned)((wid * QBLK + r32) * LDQ + hi * 8) * 2u;
#pragma unroll
    for (int d0 = 0; d0 < 8; ++d0) S.qr[d0] = GLD8(cur.Q, qoff + d0 * 32);
    SLOAD_H(cur.K, cur.V, cur.jlo * KVBLK); VMW(); SWRITE_HK(0);
    __syncthreads();
}
__device__ __forceinline__ void fox_block(const BlockRef& cur, const BlockRef& nxt, char* lds, Seam& S, int& bh_loaded, const int wid, const int jw) {
    const int lane = lane_id(), tid = wid * 64 + lane, r32 = lane & 31, hi = lane >> 5;
    const int NT = cur.P0 / KVBLK + 4 - cur.jlo;
    const unsigned W = 0x40000000u;
    const int qlo = cur.P0 + wid * QBLK, qm = qlo + r32 - 4 * hi;
    const int ta = jw - cur.jlo, tz = ((qlo + QBLK - 1) >> 6) - cur.jlo;
#define ACT(t) ((t) >= ta && (t) <= tz)
    char* V_lds = lds; char* K_lds = lds + 2 * SHM_V;
    float* ws = (float*)(lds + OFF_WS) + wid * 64; float* li_l = ws, * al_l = ws + 32;
    float* cb_l = (float*)(lds + OFF_CB);
    if (cur.bh != bh_loaded) {
#pragma unroll
        for (int i = 0; i < 2; ++i) ((f32x4*)cb_l)[tid + i * NTHR] = ((const f32x4*)cur.CB)[tid + i * NTHR];
        bh_loaded = cur.bh;
        __syncthreads();
    }
    const float* cbl = cb_l + 4 * hi;
    char* qlds = lds + OFF_QL + wid * 4096 + lane * 16;
#pragma unroll
    for (int f = 0; f < 4; ++f) *reinterpret_cast<bf16x8*>(qlds + f * 1024) = S.qr[4 + f];
    float m_reg = -1e30f, l_reg = 0; f32x16 o[4] = {};
    const int sr = tid >> 4, sc = (tid & 15) * 8, vst0 = v_st(sr, sc), vst1 = v_st(32 + sr, sc), kws = KSWZ(sr, sc * 2);
    const unsigned loff = (unsigned)(sr * LDQ + sc) * 2u, qoff = (unsigned)((wid * QBLK + r32) * LDQ + hi * 8) * 2u;
    const int vb0 = (int)(uintptr_t)V_lds + v_rd_base(lane);
    const bf16_t* Kh = cur.K; const bf16_t* Vh = cur.V;
#define RESC(a) do { if (__any((a) < 1.f)) { if (hi == 0) al_l[r32] = (a); asm volatile("s_waitcnt lgkmcnt(0)" ::: "memory");              \
                     _Pragma("unroll") for (int d_ = 0; d_ < 4; ++d_) _Pragma("unroll") for (int r = 0; r < 16; ++r) o[d_][r] *= al_l[crow(r, hi)]; } } while (0)
#define KBASE(t) ((cur.jlo + (t)) * KVBLK)
#define MASKT(P0_, P1_, t) do { const int kb_ = KBASE(t); if (kb_ + KVBLK - 1 > qlo) mask_tile(P0_, P1_, qm - kb_, W); } while (0)
    constexpr int NQL = 8;
#define SEAM_K0() do { VMWN(NQL); SWRITE_HK(0); SBAR(); } while (0)
    f32x16 pA0, pA1, pB0, pB1; float mnA, mnB, alA, alB; bf16x8 pa0, pa1, pa2, pa3;
    SWRITE_HV(0); SBAR();
    if (NT > 1) { SLOAD_H(Kh, Vh, KBASE(1)); }
    SBAR(); if (ACT(0)) { qkt<0, true, 4>(pA0, pA1, K_lds, r32, hi, S.qr, cbl + KBASE(0), qlds);
    MASKT(pA0, pA1, 0); partialSM(pA0, pA1, m_reg, mnA, alA); }
    if (NT > 1) { VMW(); SWRITE_H(1); }
    __syncthreads();
#define HALF_STEP(PX0, PX1, mnX, alX, PY0, PY1, alY, t, KB, VB, SBF) do {                                                      \
        const bool ax_ = ACT(t), ay_ = ACT((t) - 1);                                                                          \
        SBAR(); if (ax_) qkt<KB, true, 4>(PX0, PX1, K_lds, r32, hi, S.qr, cbl + KBASE(t), qlds);                                    \
        if (ay_) finishSM(PY0, PY1, alY, l_reg, pa0, pa1, pa2, pa3); SBAR();                                                  \
        if ((t) + 1 < NT) { SLOAD_H(Kh, Vh, KBASE((t) + 1)); SBAR(); }                                               \
        if (ay_) pv_tile<VB>(o, vb0, pa0, pa1, pa2, pa3); if (ax_) { MASKT(PX0, PX1, (t)); partialSM(PX0, PX1, m_reg, mnX, alX); }                  \
        __syncthreads();                                                                                                      \
        if ((t) + 1 < NT) { VMW(); SWRITE_H(SBF); }                                                                          \
        if (ax_) RESC(alX); __syncthreads(); } while (0)
    for (int t = 1; t + 1 < NT; t += 2) {
        HALF_STEP(pB0, pB1, mnB, alB, pA0, pA1, alA, t, 1, 0, 0);
        HALF_STEP(pA0, pA1, mnA, alA, pB0, pB1, alB, t + 1, 0, 1, 1);
    }
    const bool even = (NT & 1) == 0;
    const bool actL = ACT(NT - 1), actA = even ? ACT(NT - 2) : actL;
    if (even) { SBAR(); if (actL) qkt<1, true, 4>(pB0, pB1, K_lds, r32, hi, S.qr, cbl + KBASE(NT - 1), qlds); SBAR(); }
    SLOAD_H(nxt.K, nxt.V, nxt.jlo * KVBLK); SBAR();
#pragma unroll
    for (int d0 = 0; d0 < 8; ++d0) S.qr[d0] = GLD8(nxt.Q, qoff + d0 * 32);
    SBAR();
    if (actA) { finishSM(pA0, pA1, alA, l_reg, pa0, pa1, pa2, pa3); SBAR();
    pv_tile<0>(o, vb0, pa0, pa1, pa2, pa3); }
    if (even) { if (actL) { MASKT(pB0, pB1, NT - 1); partialSM(pB0, pB1, m_reg, mnB, alB); } __syncthreads(); if (actL) { RESC(alB);
        finishSM(pB0, pB1, alB, l_reg, pa0, pa1, pa2, pa3); SBAR(); pv_tile<1>(o, vb0, pa0, pa1, pa2, pa3); } }
    SBAR(); SEAM_K0();
    if (hi == 0) li_l[r32] = l_reg; asm volatile("s_waitcnt lgkmcnt(0)" ::: "memory");
    float rli[16];
#pragma unroll
    for (int r = 0; r < 16; ++r) rli[r] = __builtin_amdgcn_rcpf(li_l[crow(r, hi)]);
    const unsigned ooff = (unsigned)((wid * QBLK + 4 * hi) * LDO + r32) * 2u;
#pragma unroll
    for (int r = 0; r < 16; ++r) {
#pragma unroll
        for (int d0 = 0; d0 < 4; ++d0) { const float v = o[d0][r] * rli[r];
            const float vn = __shfl_xor(v, 1);
            if ((r32 & 1) == 0) *(unsigned*)((char*)cur.O + (ooff + (unsigned)((((r & 3) + 8 * (r >> 2)) * LDO + d0 * 32) * 2))) = cvt_pk_bf16(v, vn); } }
    __syncthreads();
#undef RESC
#undef KBASE
#undef MASKT
#undef SEAM_K0
#undef HALF_STEP
#undef ACT
}
#undef SLOAD_H

constexpr int LDQ0 = QKV0_LD;
constexpr float SB_EXIT = 9.094947e-13f;
#ifndef SB_EARLY_EXIT
#define SB_EARLY_EXIT 1
#endif
__device__ __forceinline__ void sb_block(const bf16_t* Qb, const bf16_t* Kh, const bf16_t* Vh, bf16_t* Ob, int P0, char* lds, LAS unsigned char* ldsl, const int wid) {
    const int lane = lane_id(), tid = wid * 64 + lane, r32 = lane & 31, hi = lane >> 5;
    char* V_lds = lds; char* K_lds = lds + 2 * SHM_V;
    volatile LAS int* flags = (volatile LAS int*)(ldsl + OFF_FLAG);
    const int sr = tid >> 4, sc = (tid & 15) * 8, vst0 = v_st(sr, sc), vst1 = v_st(32 + sr, sc), kws = KSWZ(sr, sc * 2);
    const int vb0 = (int)(uintptr_t)V_lds + v_rd_base(lane);
    const int qlo = P0 + wid * QBLK, qrow = qlo + r32;
    bf16x8 qr[8];
    const unsigned loff = (unsigned)(sr * LDQ0 + sc) * 2u, qoff = (unsigned)((wid * QBLK + r32) * LDQ0 + hi * 8) * 2u;
#pragma unroll
    for (int d0 = 0; d0 < 8; ++d0) qr[d0] = GLD8(Qb, qoff + d0 * 32);
    f32x16 o[4] = {};
    float R = 1.f; bool wdone = false;
    const int NT = P0 / KVBLK + 4;
    bf16x8 st_v0, st_v1, st_k0, st_k1;
#define SB_LOAD(kk0) do { const char* kb__ = (const char*)Kh + (size_t)(kk0) * (LDQ0 * 2); const char* vb__ = (const char*)Vh + (size_t)(kk0) * (LDQ0 * 2); \
                         st_v0 = GLD8(vb__, loff); st_v1 = GLD8(vb__, loff + 32u * LDQ0 * 2u); st_k0 = GLD8(kb__, loff); st_k1 = GLD8(kb__, loff + 32u * LDQ0 * 2u); } while (0)
    SB_LOAD((NT - 1) * KVBLK);
    for (int t = NT - 1; t >= 0; --t) {
        VMW();
        *(bf16x8*)(V_lds + vst0) = st_v0; *(bf16x8*)(V_lds + vst1) = st_v1;
        *(bf16x8*)(K_lds + kws) = st_k0; *(bf16x8*)(K_lds + kws + 32 * 256) = st_k1;
        if (t > 0) SB_LOAD((t - 1) * KVBLK);
        __syncthreads();
        const int kb = t * KVBLK;
        if (kb <= qlo && !wdone) {
            f32x16 p0, p1;
            qkt<0, false>(p0, p1, K_lds, r32, hi, qr, nullptr);
            f32x16 kp0, kp1;
            const int dq = qrow - kb - 4 * hi;
            const float NEGINF = -__builtin_inff();
            constexpr float CZ = ATT_SCALE * 1.4426950408889634f;
#pragma unroll
            for (int r = 0; r < 16; ++r) {
                const int c = (r & 3) + 8 * (r >> 2);
                const float z0 = (c < dq) ? p0[r] * CZ : NEGINF, z1 = (c + 32 < dq) ? p1[r] * CZ : NEGINF;
                const float e0 = __builtin_amdgcn_exp2f(-fabsf(z0)), e1 = __builtin_amdgcn_exp2f(-fabsf(z1));
                const float i0 = __builtin_amdgcn_rcpf(1.0f + e0), i1 = __builtin_amdgcn_rcpf(1.0f + e1);
                const float f0 = e0 * i0, f1 = e1 * i1;
                p0[r] = (z0 < 0.f) ? f0 : i0; kp0[r] = (z0 < 0.f) ? i0 : f0;
                p1[r] = (z1 < 0.f) ? f1 : i1; kp1[r] = (z1 < 0.f) ? i1 : f1;
            }
            float glo[2][4], ghi[2][4];
#pragma unroll
            for (int g = 0; g < 4; ++g) {
                const float t0 = (kp0[4 * g] * kp0[4 * g + 1]) * (kp0[4 * g + 2] * kp0[4 * g + 3]);
                const float t1 = (kp1[4 * g] * kp1[4 * g + 1]) * (kp1[4 * g + 2] * kp1[4 * g + 3]);
                auto r0 = __builtin_amdgcn_permlane32_swap(__float_as_uint(t0), __float_as_uint(t0), false, false);
                auto r1 = __builtin_amdgcn_permlane32_swap(__float_as_uint(t1), __float_as_uint(t1), false, false);
                glo[0][g] = __uint_as_float(r0[0]); ghi[0][g] = __uint_as_float(r0[1]);
                glo[1][g] = __uint_as_float(r1[0]); ghi[1][g] = __uint_as_float(r1[1]);
            }
            float A = R; float off[2][4];
#pragma unroll
            for (int blk = 1; blk >= 0; --blk)
#pragma unroll
                for (int g = 3; g >= 0; --g) { const float oh = A; A *= ghi[blk][g]; const float ol = A; A *= glo[blk][g]; off[blk][g] = hi ? oh : ol; }
            R = A;
#pragma unroll
            for (int g = 0; g < 4; ++g) {
                float s0 = off[0][g], s1 = off[1][g];
#pragma unroll
                for (int e = 3; e >= 0; --e) {
                    const int r = 4 * g + e;
                    const float w0 = p0[r] * s0, w1 = p1[r] * s1;
                    s0 *= kp0[r]; s1 *= kp1[r];
                    p0[r] = w0; p1[r] = w1;
                }
            }
            bf16x8 pa0, pa1, pa2, pa3;
            PK4(p0, 0, pa0); PK4(p0, 8, pa1); PK4(p1, 0, pa2); PK4(p1, 8, pa3);
            pv_tile<0>(o, vb0, pa0, pa1, pa2, pa3);
            wdone = SB_EARLY_EXIT && __all(R < SB_EXIT);
        }
        if (SB_EARLY_EXIT) { if (lane == 0) flags[wid] = wdone ? 1 : 0; }
        __syncthreads();
        if (SB_EARLY_EXIT) {
            int all = 1;
#pragma unroll
            for (int w = 0; w < NW; ++w) all &= flags[w];
            if (all) break;
        }
    }
#undef SB_LOAD
    const unsigned ooff = (unsigned)((wid * QBLK + 4 * hi) * LDO + r32) * 2u;
#pragma unroll
    for (int r = 0; r < 16; ++r) {
#pragma unroll
        for (int d0 = 0; d0 < 4; ++d0) { const float v = o[d0][r];
            const float vn = __shfl_xor(v, 1);
            if ((r32 & 1) == 0) *(unsigned*)((char*)Ob + (ooff + (unsigned)((((r & 3) + 8 * (r >> 2)) * LDO + d0 * 32) * 2))) = cvt_pk_bf16(v, vn); } }
    VMW();
    __syncthreads();
}
#undef GLD8
#undef VMW
#undef VMWN
#undef SWRITE_HK
#undef SWRITE_HV
#undef SWRITE_H
#undef PK4
}

#define XB_TMO      128
#define XB_XCNT(j)  (256  + 64 * (j))
#define XB_XSUB(j)  (1280 + 64 * (j))
#define XB_XGEN(j)  (2304 + 64 * (j))
#define XB_TOP      3328
#define XB_TOPGEN   3392
#define XCD_BAR_WORDS 3456
#define XB_SPIN_CAP (1u << 18)
__device__ __forceinline__ unsigned xb_ld(unsigned* p)              { return __hip_atomic_load(p, __ATOMIC_RELAXED, __HIP_MEMORY_SCOPE_AGENT); }
__device__ __forceinline__ unsigned xb_add(unsigned* p, unsigned v) { return __hip_atomic_fetch_add(p, v, __ATOMIC_RELAXED, __HIP_MEMORY_SCOPE_AGENT); }
__device__ __forceinline__ unsigned xb_xcc_id() { return (unsigned)__builtin_amdgcn_s_getreg((3 << 11) | 20) & 0xFu; }
#define XB_SPIN(cond, bar) do { unsigned _sp = 0; while (cond) { __builtin_amdgcn_s_sleep(1); \
    if ((++_sp & 255u) == 0u) { if (xb_ld(&(bar)[XB_TMO])) break; if (_sp > XB_SPIN_CAP) { atomicAdd(&(bar)[XB_TMO], 1u); break; } } } } while (0)
struct XcdBarrier { unsigned* bar; unsigned x; volatile LAS unsigned* st; };
__device__ __forceinline__ XcdBarrier xcd_barrier_post(unsigned* bar, volatile LAS unsigned* st, const bool t0) {
    XcdBarrier b; b.bar = bar; b.x = xb_xcc_id(); b.st = st;
    if (t0) (void)xb_add(&bar[XB_XCNT(b.x)], 1u);
    return b;
}
__device__ __forceinline__ void xcd_barrier_complete(unsigned* bar, unsigned x, unsigned& nloc, unsigned& nx) {
    const unsigned G = gridDim.x * gridDim.y * gridDim.z;
    unsigned sum, cnt, mine, sp = 0u;
    for (;;) {
        sum = 0u; cnt = 0u; mine = 0u;
#pragma unroll
        for (unsigned j = 0; j < 16; ++j) { const unsigned c = xb_ld(&bar[XB_XCNT(j)]); sum += c; cnt += (c > 0u) ? 1u : 0u; mine = (j == x) ? c : mine; }
        if (sum == G) break;
        __builtin_amdgcn_s_sleep(1);
        if ((++sp & 255u) == 0u) { if (xb_ld(&bar[XB_TMO])) break; if (sp > XB_SPIN_CAP) { atomicAdd(&bar[XB_TMO], 1u); break; } }
    }
    nloc = mine > 0u ? mine : 1u; nx = cnt > 0u ? cnt : 1u;
}
__device__ __forceinline__ void xcd_barrier(const XcdBarrier& b, const bool t0) {
    asm volatile("s_waitcnt vmcnt(0)" ::: "memory");
    __syncthreads();
    if (t0) {
        unsigned* bar = b.bar;
        __builtin_amdgcn_s_waitcnt(0);
        unsigned nloc = b.st[0], nx = b.st[1];
        if (nloc == 0u) { xcd_barrier_complete(bar, b.x, nloc, nx); b.st[0] = nloc; b.st[1] = nx; }
        const unsigned old = xb_add(&bar[XB_XSUB(b.x)], 1u);
        const unsigned gen = old / nloc;
        if (old + 1u == (gen + 1u) * nloc) {
            __builtin_amdgcn_fence(__ATOMIC_RELEASE, "agent");
            asm volatile("s_waitcnt vmcnt(0)" ::: "memory");
            const unsigned og = xb_add(&bar[XB_TOP], 1u);
            const unsigned tg = og / nx;
            if (og + 1u == (tg + 1u) * nx) xb_add(&bar[XB_TOPGEN], 1u);
            else XB_SPIN(xb_ld(&bar[XB_TOPGEN]) == tg, bar);
            __builtin_amdgcn_fence(__ATOMIC_ACQUIRE, "agent");
            xb_add(&bar[XB_XGEN(b.x)], 1u);
            asm volatile("s_waitcnt vmcnt(0)" ::: "memory");
        } else {
            XB_SPIN(xb_ld(&bar[XB_XGEN(b.x)]) == gen, bar);
            __builtin_amdgcn_fence(__ATOMIC_ACQUIRE, "agent");
            asm volatile("s_waitcnt vmcnt(0)" ::: "memory");
        }
    }
    __syncthreads();
}

__device__ __forceinline__ void transpose_item(const float* W, int K, int N, bf16_t* WT, LAS float* scr, int item, int lane, const float* gam, const float* bet, float* sdst) {
    const int nblk = N / 32, nbg = (nblk + 7) >> 3, g64 = item >> 6, r = item & 63;
    const int nb = (g64 % nbg) * 8 + (r & 7), kb = (g64 / nbg) * 8 + (r >> 3), k0 = 64 * kb, n0 = 32 * nb;
    if (nb >= nblk) return;
#pragma unroll
    for (int i = 0; i < 8; ++i) { const int kk = 8 * i + (lane >> 3), n4 = (lane & 7) * 4;
        const f32x4 w = *(const f32x4*)(W + (size_t)(k0 + kk) * N + n0 + n4); LAS float* d = scr + kk * 33 + n4; d[0] = w[0]; d[1] = w[1]; d[2] = w[2]; d[3] = w[3]; }
    if (gam) { scr[64 * 33 + lane] = gam[k0 + lane]; scr[64 * 33 + 64 + lane] = bet[k0 + lane]; }
    LDS_WAIT(); asm volatile("" ::: "memory");
    if (gam) {
        const int n = lane & 31, h = lane >> 5; float sa = 0.f, ta = 0.f;
#pragma unroll 8
        for (int i = 0; i < 32; ++i) { const int kk = h * 32 + i; const float w = scr[kk * 33 + n]; const float wg = w * scr[64 * 33 + kk];
            scr[kk * 33 + n] = wg; sa += bf_lo(f2bf(wg)); ta += w * scr[64 * 33 + 64 + kk]; }
        sa += __shfl_xor(sa, 32); ta += __shfl_xor(ta, 32);
        if (lane < 32) { unsafeAtomicAdd(sdst + n0 + lane, sa); unsafeAtomicAdd(sdst + ST_N + n0 + lane, ta); }
        LDS_WAIT(); asm volatile("" ::: "memory");
    }
    const int c = lane & 7;
#pragma unroll
    for (int j = 0; j < 4; ++j) { const int n = (lane >> 3) + 8 * j; const LAS float* s = scr + (8 * c) * 33 + n;
        u32x4 o; o.x = pk2(s[0 * 33], s[1 * 33]); o.y = pk2(s[2 * 33], s[3 * 33]); o.z = pk2(s[4 * 33], s[5 * 33]); o.w = pk2(s[6 * 33], s[7 * 33]);
        *(GAS u32x4*)(WT + (size_t)((n0 + n) >> 8) * ((size_t)K * 256) + (size_t)kb * (256 * 64) + ((n0 + n) & 255) * 64 + 8 * c) = o; }
    LDS_WAIT(); asm volatile("" ::: "memory");
}

struct Args {
    const float* in[21]; float* out; unsigned char* ws; int ph_lo, ph_hi;
};

__device__ __forceinline__ void ln_phase(const float* Yin, float* Y, bf16_t* XB, const float* gam, const float* bet, LAS unsigned char* lds, int gw, int NGW, int tid, int lane) {
    LAS f32x4* gl = (LAS f32x4*)lds; LAS f32x4* bl = (LAS f32x4*)(lds + 16384);
    for (int i = tid; i < 1024; i += NTHR) { gl[i] = ((const f32x4*)gam)[i]; bl[i] = ((const f32x4*)bet)[i]; }
    __syncthreads();
    for (int row = gw; row < MTOK; row += NGW) {
        f32x4* yr = (f32x4*)(Y + (size_t)row * DM) + lane; const f32x4* yi = (const f32x4*)(Yin + (size_t)row * DM) + lane;
        f32x4 v[16]; float s = 0.f;
#pragma unroll
        for (int j = 0; j < 16; ++j) { v[j] = yi[64 * j]; s += (v[j][0] + v[j][1]) + (v[j][2] + v[j][3]); }
        const float mean = wave_sum(s) * (1.f / DM); float s2 = 0.f;
#pragma unroll
        for (int j = 0; j < 16; ++j) { v[j] = v[j] - mean; s2 += (v[j][0] * v[j][0] + v[j][1] * v[j][1]) + (v[j][2] * v[j][2] + v[j][3] * v[j][3]); }
        const float rstd = 1.f / sqrtf(wave_sum(s2) * (1.f / DM) + LN_EPS);
        u32x2* xo = (u32x2*)(XB + (size_t)row * DM) + lane;
#pragma unroll
        for (int j = 0; j < 16; ++j) { const f32x4 o = v[j] * rstd * gl[64 * j + lane] + bl[64 * j + lane]; yr[64 * j] = o;
            u32x2 w; w.x = cvt_pk_bf16(o[0], o[1]); w.y = cvt_pk_bf16(o[2], o[3]); xo[64 * j] = w; }
    }
    __syncthreads();
}

__device__ __forceinline__ void ln_final(const bf16_t* XB, float* Y, const f32x2* PS, const float* gam, const float* bet, LAS unsigned char* lds, int gw, int NGW, int wave) {
    LAS f32x4* gl = (LAS f32x4*)lds; LAS f32x4* bl = (LAS f32x4*)(lds + 16384);
    { const int t0 = wave * 64 + lane_id(); gl[t0] = ((const f32x4*)gam)[t0]; bl[t0] = ((const f32x4*)bet)[t0]; gl[t0 + 512] = ((const f32x4*)gam)[t0 + 512]; bl[t0 + 512] = ((const f32x4*)bet)[t0 + 512]; }
    __syncthreads();
    for (int row = gw; row < MTOK; row += NGW) {
        const int lane = lane_id();
        char* yb = (char*)(Y + (size_t)row * DM); const char* xb = (const char*)(XB + (size_t)(row >> 8) * (BM_ * DM) + (row & 255) * 64);
        const unsigned lo16 = (unsigned)((lane >> 3) * (BM_ * 64) + (lane & 7) * 8) * 2u, lo32 = (unsigned)lane * 32u;
        float mu, rr; { const f32x2 pv = PS[(size_t)row * 64 + lane]; const float a = wave_sum(pv.x), b = wave_sum(pv.y); mu = a * (1.f / DM); rr = 1.f / sqrtf(fmaxf(b * (1.f / DM) - mu * mu, 0.f) + LN_EPS); }
        asm volatile("" ::: "memory");
        u32x4 v[8];
#pragma unroll
        for (int j = 0; j < 8; ++j) v[j] = *(const u32x4*)(xb + (lo16 + j * (8 * BM_ * 64 * 2)));
#pragma unroll
        for (int j = 0; j < 8; ++j) { const int q = (64 * j + lane) * 2;
            const f32x4 a = (f32x4){bf_lo(v[j].x), bf_hi(v[j].x), bf_lo(v[j].y), bf_hi(v[j].y)}, b = (f32x4){bf_lo(v[j].z), bf_hi(v[j].z), bf_lo(v[j].w), bf_hi(v[j].w)};
            *(f32x4*)(yb + (lo32 + j * 2048)) = (a - mu) * rr * gl[q] + bl[q]; *(f32x4*)(yb + (lo32 + j * 2048 + 16)) = (b - mu) * rr * gl[q + 1] + bl[q + 1]; }
    }
    __syncthreads();
}

constexpr int N_PHASES = 19;
static_assert(sizeof(Args) == 192, "Args layout: in[21] @0, out @168, ws @176, ph_lo @184, ph_hi @188");
__global__ void __launch_bounds__(NTHR, 2) mega_fwd(Args) {
    extern __shared__ __attribute__((aligned(16))) unsigned char lds_raw[];
    LAS unsigned char* lds = (LAS unsigned char*)lds_raw;
    volatile LAS unsigned* MISC = (volatile LAS unsigned*)(lds + MISC_OFF);
    const int wave = __builtin_amdgcn_readfirstlane((int)threadIdx.x >> 6);
#define TIDLANE() const int lane = lane_id(); const int tid = wave * 64 + lane; (void)tid
    const int G = gridDim.x, bx = blockIdx.x;
    const int gw = bx * NWAVES + wave, NGW = G * NWAVES;
    { TIDLANE(); for (int u = tid; u < (LDS_BYTES - RING_BYTES) / 4; u += NTHR) ((LAS unsigned*)(lds + RING_BYTES))[u] = 0u; }
    __syncthreads();
#define WSBASE() const AS4 unsigned char* kp_ = (const AS4 unsigned char*)__builtin_amdgcn_kernarg_segment_ptr(); asm volatile("" : "+s"(kp_)); \
                 unsigned char* wsb = *(unsigned char* const AS4*)(kp_ + 176); float* outp = *(float* const AS4*)(kp_ + 168); (void)outp; (void)wsb
#define WSP(T, off) ((T*)(wsb + (off)))
#define INP(k) (*(const float* const AS4*)(kp_ + 8 * (k)))
#if MK_ONE_LAUNCH
    { WSBASE(); (void)xcd_barrier_post((unsigned*)(wsb + WS_CTL) + CW_BAR, MISC + 8, wave == 0 && lane_id() == 0); }
#define GRID_BAR() do { WSBASE(); XcdBarrier bar_; bar_.bar = (unsigned*)(wsb + WS_CTL) + CW_BAR; bar_.x = xb_xcc_id(); bar_.st = MISC + 8; xcd_barrier(bar_, wave == 0 && lane_id() == 0); } while (0)
#else
#define GRID_BAR() do {} while (0)
#endif
    int lo, hi; { const AS4 int* kq = (const AS4 int*)__builtin_amdgcn_kernarg_segment_ptr(); lo = kq[46]; hi = kq[47]; }
#ifndef PH_MASK
#define PH_MASK 0x7FFFF
#endif
#define IN(k) (((PH_MASK >> (k)) & 1) && lo <= (k) && (k) < hi)
#define BOTH(k) (IN(k) && IN((k) + 1))
#ifndef PROBE_REP
#define PROBE_REP -1
#endif
#define NREP(k) ((PROBE_REP) == (k) ? 2 : 1)
#define PSCR(k) ((PROBE_REP) == (k) && rep_ == 0)

    for (int rep_ = 0; rep_ < NREP(0); ++rep_) if (IN(0)) {
        WSBASE(); TIDLANE();
        {
            const float* a_re = INP(2); const float* a_im = INP(3); const float* log_dt = INP(4);
            const float* b_re = INP(5); const float* b_im = INP(6); const float* c_re = INP(7); const float* c_im = INP(8);
            bf16_t* BT2 = WSP(bf16_t, WS_BT2); bf16_t* BT1 = WSP(bf16_t, WS_BT1); f32x2* A16 = WSP(f32x2, WS_A16);
            LAS f32x2* pw = (LAS f32x2*)lds;
            LAS f32x2* bb = (LAS f32x2*)(lds + 16384);
            LAS f32x2* cc = (LAS f32x2*)(lds + 32768);
            LAS float* Kt = (LAS float*)(lds + 49152);
            for (int g = bx; g < SSM_G; g += G) {
                if (tid < 64) {
                    const int n = tid;
                    const double lr = (double)a_re[g * 64 + n], li = (double)a_im[g * 64 + n], dt = exp((double)log_dt[g]);
                    const double mag = exp(lr * dt); double sn, cs; sincos(li * dt, &sn, &cs);
                    const double ar = mag * cs, ai = mag * sn;
                    const double den = lr * lr + li * li, nr = ar - 1.0, ni = ai;
                    const double zr = (nr * lr + ni * li) / den, zi = (ni * lr - nr * li) / den;
                    double pr = 1.0, pi = 0.0;
                    pw[n] = (f32x2){1.f, 0.f};
                    for (int tau = 1; tau <= 16; ++tau) { const double t0 = pr * ar - pi * ai, t1 = pr * ai + pi * ar; pr = t0; pi = t1; pw[tau * 64 + n] = (f32x2){(float)pr, (float)pi}; }
                    A16[g * 64 + n] = (f32x2){(float)pr, (float)pi};
                    for (int q = 0; q < 16; ++q) { const double br = (double)b_re[(size_t)(g * 64 + n) * 16 + q], bi = (double)b_im[(size_t)(g * 64 + n) * 16 + q];
                        bb[n * 16 + q] = (f32x2){(float)(zr * br - zi * bi), (float)(zr * bi + zi * br)}; }
                }
                for (int i = tid; i < 1024; i += NTHR) cc[i] = (f32x2){c_re[(size_t)g * 1024 + i], c_im[(size_t)g * 1024 + i]};
                __syncthreads();
                for (int idx = tid; idx < 4096; idx += NTHR) {
                    const int tau = idx >> 8, p = (idx >> 4) & 15, q = idx & 15; float acc = 0.f;
                    for (int n = 0; n < 64; ++n) { const f32x2 c = cc[p * 64 + n], a = pw[tau * 64 + n], b = bb[n * 16 + q];
                        const float cr = c.x * a.x - c.y * a.y, ci = c.x * a.y + c.y * a.x; acc += cr * b.x - ci * b.y; }
                    Kt[idx] = acc;
                }
                __syncthreads();
                for (int idx = tid; idx < 256 * 384; idx += NTHR) {
                    const int r = idx / 384, cidx = idx % 384, t = r >> 4, p = r & 15; float v;
                    if (cidx < 256) { const int s_ = cidx >> 4, q = cidx & 15; v = (s_ <= t) ? Kt[((t - s_) << 8) + (p << 4) + q] : 0.f; }
                    else { const int j = cidx - 256, n = j & 63; const f32x2 c = cc[p * 64 + n], a = pw[(t + 1) * 64 + n];
                        v = (j < 64) ? (c.x * a.x - c.y * a.y) : -(c.x * a.y + c.y * a.x); }
                    BT2[(size_t)g * 256 * 384 + idx] = (bf16_t)f2bf(v);
                }
                for (int idx = tid; idx < 256 * 256; idx += NTHR) {
                    const int j = idx >> 8, cidx = idx & 255, s_ = cidx >> 4, q = cidx & 15; float v = 0.f;
                    if (j < 128) { const int n = j & 63; const f32x2 a = pw[(15 - s_) * 64 + n], b = bb[n * 16 + q];
                        v = (j < 64) ? (a.x * b.x - a.y * b.y) : (a.x * b.y + a.y * b.x); }
                    BT1[(size_t)g * 65536 + idx] = (bf16_t)f2bf(v);
                }
                __syncthreads();
            }
        }
        {
            LAS float* scr = (LAS float*)(lds + wave * 16384);
            constexpr int NI0 = 64 * 256, NI1 = 32 * 64, NI2 = 64 * 128, NI3 = 64 * 512, NI4 = 256 * 128, NI5 = 64 * 8 * ((FOX_IN / 32 + 7) / 8), NI6 = 64 * 128, NI7 = NI3, NI8 = NI4;
            constexpr int NITOT = NI0 + NI1 + NI2 + NI3 + NI4 + NI5 + NI6 + NI7 + NI8;
            for (int it = gw; it < NITOT; it += NGW) {
                int r = it; const float* src; bf16_t* dst; int KK, NN; const float* gam = nullptr; const float* bet = nullptr; float* sd = nullptr;
                if (r < NI0) { src = INP(1); KK = 4096; NN = 8192; dst = WSP(bf16_t, WS_W_IN0); }
                else if ((r -= NI0) < NI1) { src = INP(10); KK = 2048; NN = 2048; dst = WSP(bf16_t, WS_W_GLU); }
                else if ((r -= NI1) < NI2) { src = INP(11); KK = 4096; NN = 4096; dst = WSP(bf16_t, WS_W_OUT0); }
                else if ((r -= NI2) < NI3) { src = INP(17); KK = 4096; NN = 16384; dst = WSP(bf16_t, WS_W1_0); gam = INP(15); bet = INP(16); sd = WSP(float, WS_ST); }
                else if ((r -= NI3) < NI4) { src = INP(18); KK = 16384; NN = 4096; dst = WSP(bf16_t, WS_W2_0); }
                else if ((r -= NI4) < NI5) { src = INP(12); KK = 4096; NN = FOX_IN; dst = WSP(bf16_t, WS_W_IN1); gam = INP(19); bet = INP(20); sd = WSP(float, WS_ST) + 2 * ST_N; }
                else if ((r -= NI5) < NI6) { src = INP(14); KK = 4096; NN = 4096; dst = WSP(bf16_t, WS_W_OUT1); }
                else if ((r -= NI6) < NI7) { src = INP(17) + (size_t)4096 * 16384; KK = 4096; NN = 16384; dst = WSP(bf16_t, WS_W1_1); gam = INP(15) + DM; bet = INP(16) + DM; sd = WSP(float, WS_ST) + 4 * ST_N; }
                else { r -= NI7; src = INP(18) + (size_t)4096 * 16384; KK = 16384; NN = 4096; dst = WSP(bf16_t, WS_W2_1); }
                transpose_item(src, KK, NN, dst, scr, r, lane, gam, bet, sd);
            }
            { const int n16 = (FOX_INP - FOX_IN) * 4096 / 8; u32x4* z = (u32x4*)(WSP(bf16_t, WS_W_IN1) + (size_t)48 * 256 * 4096);
              for (int i = gw * 64 + lane; i < n16; i += NGW * 64) { const int kt = i / (224 * 8), r = i % (224 * 8); z[(size_t)kt * (256 * 8) + 32 * 8 + r] = (u32x4){0u, 0u, 0u, 0u}; } }
            { const int n8 = MTOK * DM / 8; const f32x4* x4 = (const f32x4*)INP(0); u32x4* xb = WSP(u32x4, WS_XB);
              for (int i = gw * 64 + lane; i < n8; i += NGW * 64) { const f32x4 a = x4[2 * i], b = x4[2 * i + 1];
                  const int row = i >> 9, c8 = i & 511;
                  xb[(size_t)(row >> 8) * (BM_ * DM / 8) + (size_t)(c8 >> 3) * (BM_ * 8) + (row & 255) * 8 + (c8 & 7)] = pack8f(a, b); } }
        }
        __syncthreads();
        if (BOTH(0)) GRID_BAR();
    }
    for (int rep_ = 0; rep_ < NREP(1); ++rep_) if (IN(1)) {
        WSBASE();
        pg8::Gemm g{WSP(bf16_t, WS_XB), WSP(bf16_t, WS_W_IN0), 64, 64, DM, 32768, (size_t)BM_ * DM * 2, 32768, (size_t)BM_ * DM * 2}; pg8::StaticOrder S; S.init(MTOK, EVEN_IN, G, bx);
        pg8::EpiIn0 E{WSP(bf16_t, WS_UA), WSP(bf16_t, WS_QKV0)};
        pg8::gemm_phase<pg8::EpiIn0, pg8::StaticOrder, true>(lds, g, S, E, wave);
        if (BOTH(1)) GRID_BAR();
    }
    for (int rep_ = 0; rep_ < NREP(2); ++rep_) if (IN(2)) {
        { WSBASE(); pg8::Gemm g{WSP(bf16_t, WS_UA), WSP(bf16_t, WS_BT1), UA_LD, 256, 256}; pg8::GroupOrder S; S.init(512, G, bx);
          pg8::EpiS1 E{WSP(float, WS_XLOC)};
          pg8::gemm_phase<pg8::EpiS1, pg8::GroupOrder, true>(lds, g, S, E, wave); }
        VM_WAIT(); __syncthreads();
        {
            const int lane = lane_id(); WSBASE(); const f32x2* A16 = WSP(f32x2, WS_A16); const float* XLOC = WSP(float, WS_XLOC); bf16_t* UA = WSP(bf16_t, WS_UA);
            for (int task = bx + wave * G; task < 512; task += NWAVES * G) {
                const int g = task >> 2, b = task & 3, n = lane;
                const f32x2 a16 = A16[g * 64 + n];
                const size_t row0 = (size_t)g * 1024 + b * 256;
                float xr = 0.f, xi = 0.f;
                const float* xl = XLOC + row0 * 128 + n;
                float lr[32], li[32];
#pragma unroll
                for (int k = 0; k < 32; ++k) { lr[k] = xl[(size_t)k * 128]; li[k] = xl[(size_t)k * 128 + 64]; }
                for (int c0 = 0; c0 < 256; c0 += 32) {
                    float nr_[32], ni_[32];
                    const int cn = (c0 + 32 < 256) ? c0 + 32 : c0;
#pragma unroll
                    for (int k = 0; k < 32; ++k) { nr_[k] = xl[(size_t)(cn + k) * 128]; ni_[k] = xl[(size_t)(cn + k) * 128 + 64]; }
#pragma unroll
                    for (int k = 0; k < 32; ++k) {
                        bf16_t* dst = UA + (row0 + c0 + k) * UA_LD + 256;
                        dst[n] = (bf16_t)f2bf(xr); dst[64 + n] = (bf16_t)f2bf(xi);
                        const float nr = a16.x * xr - a16.y * xi + lr[k], ni = a16.x * xi + a16.y * xr + li[k];
                        xr = nr; xi = ni;
                    }
#pragma unroll
                    for (int k = 0; k < 32; ++k) { lr[k] = nr_[k]; li[k] = ni_[k]; }
                }
            }
        }
        VM_WAIT(); __syncthreads();
        { WSBASE(); pg8::Gemm g{WSP(bf16_t, WS_UA), WSP(bf16_t, WS_BT2), UA_LD, UA_LD, UA_LD}; pg8::GroupOrder S; S.init(512, G, bx);
          pg8::EpiS2 E{WSP(bf16_t, WS_UA), INP(9), WSP(bf16_t, WS_GACT)};
          pg8::gemm_phase<pg8::EpiS2, pg8::GroupOrder, true>(lds, g, S, E, wave); }
        {
            WSBASE(); const bf16_t* QKV0 = WSP(bf16_t, WS_QKV0); bf16_t* CONCAT = WSP(bf16_t, WS_CONCAT);
            for (int L = bx; L < NB * SB_H * (SEQ / 256); L += G) {
                const int qb = ((L >> 8) & 1) ? 15 - (L & 15) : (L & 15), bh = L >> 4, b = bh >> 4, h = bh & 15;
                const size_t tok0 = (size_t)b * SEQ;
                const bf16_t* Qb = QKV0 + (tok0 + qb * 256) * QKV0_LD + h * HD;
                const bf16_t* Kh = QKV0 + tok0 * QKV0_LD + 2048 + h * HD;
                const bf16_t* Vh = QKV0 + tok0 * QKV0_LD + 4096 + h * HD;
                bf16_t* Ob = CONCAT + (tok0 + qb * 256) * DM + W_SSM + h * HD;
                att::sb_block(Qb, Kh, Vh, Ob, qb * 256, (char*)lds_raw, lds, wave);
            }
        }
        if (BOTH(2)) GRID_BAR();
    }
    for (int rep_ = 0; rep_ < NREP(5); ++rep_) if (IN(5)) {
        WSBASE();
        pg8::Gemm g{WSP(bf16_t, WS_GACT), WSP(bf16_t, WS_W_GLU), W_SSM, 64, W_SSM, pg8::BK * 2, 0, 32768, (size_t)BM_ * W_SSM * 2}; pg8::StaticOrder S; S.init(MTOK, W_SSM, G, bx);
        pg8::EpiGlu E{WSP(bf16_t, WS_GACT), WSP(bf16_t, WS_CONCAT)};
        pg8::gemm_phase<pg8::EpiGlu, pg8::StaticOrder, true>(lds, g, S, E, wave);
        if (BOTH(5)) GRID_BAR();
    }
    for (int rep_ = 0; rep_ < NREP(6); ++rep_) if (IN(6)) {
        WSBASE();
        pg8::Gemm g{WSP(bf16_t, WS_CONCAT), WSP(bf16_t, WS_W_OUT0), DM, 64, DM, pg8::BK * 2, 0, 32768, (size_t)BM_ * DM * 2}; pg8::StaticOrder S; S.init(MTOK, DM, G, bx);
        pg8::EpiResLN<2, false> E{nullptr, WSP(bf16_t, WS_XB), nullptr, nullptr, 0, nullptr, nullptr, WSP(f32x2, WS_PS)};
        pg8::gemm_phase<pg8::EpiResLN<2, false>, pg8::StaticOrder, true>(lds, g, S, E, wave);
        if (BOTH(6)) GRID_BAR();
    }
    for (int rep_ = 0; rep_ < NREP(8); ++rep_) if (IN(8)) {
        WSBASE();
        pg8::Gemm g{WSP(bf16_t, WS_XB), WSP(bf16_t, WS_W1_0), 64, 64, DM, 32768, (size_t)BM_ * DM * 2, 32768, (size_t)BM_ * DM * 2}; pg8::StaticOrder S; S.init(MTOK, DFF, G, bx);
        pg8::EpiLN<1, DFF, true> E{WSP(bf16_t, WS_HID), WSP(f32x2, WS_PS), 0, WSP(float, WS_ST), WSP(float, WS_ST) + ST_N};
        pg8::gemm_phase<pg8::EpiLN<1, DFF, true>, pg8::StaticOrder, true>(lds, g, S, E, wave);
        if (BOTH(8)) GRID_BAR();
    }
    for (int rep_ = 0; rep_ < NREP(9); ++rep_) if (IN(9)) {
        WSBASE();
        pg8::Gemm g{WSP(bf16_t, WS_HID), WSP(bf16_t, WS_W2_0), 64, 64, DFF, 32768, (size_t)BM_ * DFF * 2, 32768, (size_t)BM_ * DFF * 2};   pg8::StaticOrder S; S.init(MTOK, DM, G, bx);
        pg8::EpiResLN<1, false> E{nullptr, WSP(bf16_t, WS_XB), nullptr, WSP(f32x2, WS_PS), 0, INP(15), INP(16), WSP(f32x2, WS_PS) + PS_STRIDE};
        pg8::gemm_phase<pg8::EpiResLN<1, false>, pg8::StaticOrder, true>(lds, g, S, E, wave);
        if (BOTH(9)) GRID_BAR();
    }
    for (int rep_ = 0; rep_ < NREP(11); ++rep_) if (IN(11)) {
        WSBASE();
        pg8::Gemm g{WSP(bf16_t, WS_XB), WSP(bf16_t, WS_W_IN1), 64, 64, DM, 32768, (size_t)BM_ * DM * 2, 32768, (size_t)BM_ * DM * 2}; pg8::StaticOrder S; S.init(MTOK, FOX_INP, G, bx);
        pg8::EpiIn1LN E{WSP(bf16_t, WS_QKV1), WSP(float, WS_FLOG), WSP(f32x2, WS_PS) + PS_STRIDE, 1, WSP(float, WS_ST) + 2 * ST_N, WSP(float, WS_ST) + 3 * ST_N};
        pg8::gemm_phase<pg8::EpiIn1LN, pg8::StaticOrder, true>(lds, g, S, E, wave);
        if (BOTH(11)) GRID_BAR();
    }
    for (int rep_ = 0; rep_ < NREP(12); ++rep_) if (IN(12)) {
        TIDLANE(); WSBASE(); const float* FLOG = WSP(float, WS_FLOG); float* CB = WSP(float, WS_CB); const float* fox_b_f = INP(13);
        {
            const bf16_t* QKV1 = WSP(bf16_t, WS_QKV1); unsigned* NRM = WSP(unsigned, WS_NRM);
            LAS float* red = (LAS float*)(lds + 1024);
            for (int rb = bx; rb < MTOK / 64; rb += G) {
                float mq[8], mk[8], md[8];
#pragma unroll
                for (int j = 0; j < 8; ++j) { mq[j] = 0.f; mk[j] = 0.f; md[j] = 0.f; }
                for (int i = 0; i < 8; ++i) {
                    const u32x4* rowp = (const u32x4*)(QKV1 + (size_t)(rb * 64 + wave * 8 + i) * QKV1_LD) + lane;
#pragma unroll
                    for (int j = 0; j < 8; ++j) {
                        const u32x4 a = rowp[64 * j], c = rowp[512 + 64 * j];
                        float sq = 0.f, sk = 0.f, sd = 0.f;
#pragma unroll
                        for (int e = 0; e < 4; ++e) { const float a0 = bf_lo(a[e]), a1 = bf_hi(a[e]), c0 = bf_lo(c[e]), c1 = bf_hi(c[e]); sq += a0 * a0 + a1 * a1; sk += c0 * c0 + c1 * c1; sd += a0 * c0 + a1 * c1; }
#pragma unroll
                        for (int o = 1; o < 16; o <<= 1) { sq += __shfl_xor(sq, o); sk += __shfl_xor(sk, o); sd += __shfl_xor(sd, o); }
                        mq[j] = fmaxf(mq[j], sq); mk[j] = fmaxf(mk[j], sk); md[j] = fminf(md[j], sd);
                    }
                }
                if ((lane & 15) == 0) {
#pragma unroll
                    for (int j = 0; j < 8; ++j) { red[wave * 64 + j * 4 + (lane >> 4)] = mq[j]; red[wave * 64 + 32 + j * 4 + (lane >> 4)] = mk[j]; red[512 + wave * 32 + j * 4 + (lane >> 4)] = md[j]; }
                }
                __syncthreads();
                if (tid < 64) { float m = red[tid];
#pragma unroll
                    for (int w = 1; w < 8; ++w) m = fmaxf(m, red[w * 64 + tid]);
                    const int b = (rb * 64) >> 12;
                    atomicMax(NRM + (tid >> 5) * 128 + b * 32 + (tid & 31), __float_as_uint(m)); }
                else if (tid < 96) { const int h = tid - 64; float m = red[512 + h];
#pragma unroll
                    for (int w = 1; w < 8; ++w) m = fminf(m, red[512 + w * 32 + h]);
                    const int b = (rb * 64) >> 12, qb = ((rb * 64) & (SEQ - 1)) >> 8; int key = __float_as_int(m); if (key < 0) key ^= 0x7fffffff;
                    atomicMin(WSP(int, WS_DMIN) + (b * 32 + h) * 16 + qb, key); }
                __syncthreads();
            }
        }
        LAS float* wsum = (LAS float*)lds;
        for (int bh = bx; bh < NB * FOX_H; bh += G) {
            const int b = bh >> 5, h = bh & 31; const float bf = fox_b_f[h];
            float v[8]; float run = 0.f;
#pragma unroll
            for (int i = 0; i < 8; ++i) { const float xx = FLOG[(size_t)bh * SEQ + tid * 8 + i] + bf;
                const float ls = fminf(xx, 0.f) - 0.6931471805599453f * __builtin_amdgcn_logf(1.0f + __builtin_amdgcn_exp2f(-fabsf(xx) * 1.4426950408889634f));
                run += ls; v[i] = run; }
            float inc = run;
#pragma unroll
            for (int o = 1; o < 64; o <<= 1) { const float t = __shfl_up(inc, o); if (lane >= o) inc += t; }
            if (lane == 63) wsum[wave] = inc;
            __syncthreads();
            float base = inc - run;
            for (int w = 0; w < wave; ++w) base += wsum[w];
#pragma unroll
            for (int i = 0; i < 8; ++i) CB[(size_t)bh * SEQ + tid * 8 + i] = -(base + v[i]) * 11.313708498984761f;
            __syncthreads();
        }
        if (BOTH(12)) GRID_BAR();
    }
    for (int rep_ = 0; rep_ < NREP(13); ++rep_) if (IN(13)) {
        WSBASE(); const bf16_t* QKV1 = WSP(bf16_t, WS_QKV1); bf16_t* ATT = WSP(bf16_t, WS_ATT); const float* CB = WSP(float, WS_CB);
        const int total = NB * FOX_H * 8;
        if (bx < total) {
            volatile LAS int* JLO = (volatile LAS int*)(lds + MISC_OFF) + 16;
            {
                const int lane = lane_id(); int bh, y;
                if (att::fox_item(bx, wave >> 1, G, total, bh, y)) {
                    const int qb = (wave & 1) ? 15 - y : y, P0 = qb * 256;
                    const unsigned* NRM = WSP(unsigned, WS_NRM);
                    const float qk = sqrtf(__uint_as_float(NRM[bh]) * __uint_as_float(NRM[128 + bh])) * 1.0001f;
                    int dk = WSP(int, WS_DMIN)[bh * 16 + qb]; if (dk < 0) dk ^= 0x7fffffff; const float dmin = fminf(__int_as_float(dk), 0.f);
                    const float cbe = CB[(size_t)bh * SEQ + lane * 64 + 63], base = dmin - qk - 340.f;
#pragma unroll
                    for (int s_ = 0; s_ < 8; ++s_) {
                        const int r0 = P0 + 32 * s_; const float thr = CB[(size_t)bh * SEQ + r0] + base;
                        const bool prun = (lane * 64 + 63 < r0) && (cbe < thr);
                        const unsigned long long mask = __ballot(prun);
                        const int js = (int)__builtin_ctzll(~mask);
                        if (lane == 0) JLO[wave * 8 + s_] = js;
                    }
                } else if (lane < 8) JLO[wave * 8 + lane] = 0;
            }
            __syncthreads();
            att::Seam S; int bh_loaded = -1;
            int k = 0, pass = 0, slot = 0, bh, y, bhn, yn;
            (void)att::fox_item(bx, 0, G, total, bh, y);
            att::BlockRef cur = att::fox_ref(bh, y, 0, QKV1, ATT, CB, __builtin_amdgcn_readfirstlane(JLO[0]));
            att::fox_prime(cur, (char*)lds_raw, S, wave);
            for (;;) {
                const bool more_pass = pass == 0, more_item = att::fox_item(bx, k + 1, G, total, bhn, yn), last = !more_pass && !more_item;
                int passn = 1, kn = k;
                if (more_pass) { bhn = bh; yn = y; } else { passn = 0; kn = k + 1; }
                const int jn = slot + 1 < NWAVES ? __builtin_amdgcn_readfirstlane(JLO[(slot + 1) * 8]) : 0;
                const int jw = slot < NWAVES ? __builtin_amdgcn_readfirstlane(JLO[slot * 8 + wave]) : 0;
                const att::BlockRef nxt = last ? cur : att::fox_ref(bhn, yn, passn, QKV1, ATT, CB, jn);
                att::fox_block(cur, nxt, (char*)lds_raw, S, bh_loaded, wave, jw);
                if (last) break;
                cur = nxt; bh = bhn; y = yn; k = kn; pass = passn; ++slot;
            }
            VM_WAIT(); __syncthreads();
        }
        if (BOTH(13)) GRID_BAR();
    }
    for (int rep_ = 0; rep_ < NREP(14); ++rep_) if (IN(14)) {
        WSBASE();
        pg8::Gemm g{WSP(bf16_t, WS_ATT), WSP(bf16_t, WS_W_OUT1), DM, 64, DM, pg8::BK * 2, 0, 32768, (size_t)BM_ * DM * 2}; pg8::StaticOrder S; S.init(MTOK, DM, G, bx);
        pg8::EpiResLN<1, false> E{nullptr, WSP(bf16_t, WS_XB), nullptr, WSP(f32x2, WS_PS) + PS_STRIDE, 1, INP(19), INP(20), WSP(f32x2, WS_PS) + 2 * PS_STRIDE};
        pg8::gemm_phase<pg8::EpiResLN<1, false>, pg8::StaticOrder, true>(lds, g, S, E, wave);
        if (BOTH(14)) GRID_BAR();
    }
    for (int rep_ = 0; rep_ < NREP(16); ++rep_) if (IN(16)) {
        WSBASE();
        pg8::Gemm g{WSP(bf16_t, WS_XB), WSP(bf16_t, WS_W1_1), 64, 64, DM, 32768, (size_t)BM_ * DM * 2, 32768, (size_t)BM_ * DM * 2}; pg8::StaticOrder S; S.init(MTOK, DFF, G, bx);
        pg8::EpiLN<1, DFF, true> E{WSP(bf16_t, WS_HID), WSP(f32x2, WS_PS) + 2 * PS_STRIDE, 2, WSP(float, WS_ST) + 4 * ST_N, WSP(float, WS_ST) + 5 * ST_N};
        pg8::gemm_phase<pg8::EpiLN<1, DFF, true>, pg8::StaticOrder, true>(lds, g, S, E, wave);
        if (BOTH(16)) GRID_BAR();
    }
    for (int rep_ = 0; rep_ < NREP(17); ++rep_) if (IN(17)) {
        WSBASE();
        pg8::Gemm g{WSP(bf16_t, WS_HID), WSP(bf16_t, WS_W2_1), 64, 64, DFF, 32768, (size_t)BM_ * DFF * 2, 32768, (size_t)BM_ * DFF * 2};   pg8::StaticOrder S; S.init(MTOK, DM, G, bx);
        pg8::EpiResLN<1, false> E{nullptr, WSP(bf16_t, WS_XB), nullptr, WSP(f32x2, WS_PS) + 2 * PS_STRIDE, 2, INP(15) + DM, INP(16) + DM, WSP(f32x2, WS_PS) + 3 * PS_STRIDE};
        pg8::gemm_phase<pg8::EpiResLN<1, false>, pg8::StaticOrder, true>(lds, g, S, E, wave);
        if (BOTH(17)) GRID_BAR();
    }
    for (int rep_ = 0; rep_ < NREP(18); ++rep_) if (IN(18)) { WSBASE(); ln_final(WSP(bf16_t, WS_XB), PSCR(18) ? WSP(float, WS_SCR) : outp, WSP(f32x2, WS_PS) + 3 * PS_STRIDE, INP(19) + DM, INP(20) + DM, lds, gw, NGW, wave); }
#undef IN
#undef BOTH
}

extern "C" void kernel_launch(void* const* d_in, const int* in_sizes, int n_in, void* d_out, int out_size, void* d_ws, size_t ws_size, hipStream_t stream) {
    static int grid = 0;
    if (grid == 0) {
        if (n_in != 21 || out_size != MTOK * DM || ws_size < WS_NEED + ((PROBE_REP) >= 0 ? 384 * MiB : 0)) { fprintf(stderr, "kernel_launch: unexpected shapes (n_in %d, out %d, ws %zu, need %zu)\n", n_in, out_size, ws_size, (size_t)WS_END); grid = -1; return; }
        int dev = 0, cus = 0, per_cu = 0;
        if (hipGetDevice(&dev) != hipSuccess || hipDeviceGetAttribute(&cus, hipDeviceAttributeMultiprocessorCount, dev) != hipSuccess) { grid = -1; return; }
        if (hipFuncSetAttribute((const void*)mega_fwd, hipFuncAttributeMaxDynamicSharedMemorySize, LDS_BYTES) != hipSuccess) { fprintf(stderr, "kernel_launch: hipFuncSetAttribute failed\n"); grid = -1; return; }
        if (hipOccupancyMaxActiveBlocksPerMultiprocessor(&per_cu, (const void*)mega_fwd, NTHR, LDS_BYTES) != hipSuccess || per_cu < 1)
            fprintf(stderr, "kernel_launch: occupancy query reports %d blocks per CU\n", per_cu);
        (void)hipGetLastError();
        grid = cus;
    }
    if (grid < 0) return;
    (void)hipMemsetAsync((char*)d_ws + WS_CTL, 0, CTL_ZERO_BYTES, stream);
    Args a{};
    for (int i = 0; i < 21; ++i) a.in[i] = (const float*)d_in[i];
    a.out = (float*)d_out; a.ws = (unsigned char*)d_ws;
#if MK_ONE_LAUNCH
    a.ph_lo = 0; a.ph_hi = N_PHASES;
    hipLaunchKernelGGL(mega_fwd, dim3(grid), dim3(NTHR), LDS_BYTES, stream, a);
#else
    for (int p = 0; p < N_PHASES; ++p) { a.ph_lo = p; a.ph_hi = p + 1; hipLaunchKernelGGL(mega_fwd, dim3(grid), dim3(NTHR), LDS_BYTES, stream, a); }
#endif
}
```

```cpp
#include <hip/hip_runtime.h>
#include <cstdio>
#include <cstdint>

#ifndef MK_ONE_LAUNCH
#define MK_ONE_LAUNCH 1
#endif

#define LAS __attribute__((address_space(3)))
#define GAS __attribute__((address_space(1)))
#define AS4 __attribute__((address_space(4)))
typedef unsigned short bf16_t;
typedef short bf16x8 __attribute__((ext_vector_type(8)));
typedef short s16x4 __attribute__((ext_vector_type(4)));
typedef float f32x2 __attribute__((ext_vector_type(2)));
typedef float f32x4 __attribute__((ext_vector_type(4)));
typedef float f32x16 __attribute__((ext_vector_type(16)));
typedef unsigned u32x2 __attribute__((ext_vector_type(2)));
typedef unsigned u32x4 __attribute__((ext_vector_type(4)));

constexpr int DM = 4096, NB = 4, SEQ = 4096, MTOK = NB * SEQ;
constexpr int HD = 128;
constexpr int W_SSM = 2048, SSM_G = 128, SSM_P = 16, SSM_N = 64, SSM_L = 16;
constexpr int SB_H = 16, EVEN_IN = 8192, FOX_H = 32, FOX_IN = 12320, FOX_INP = 12544, DFF = 16384;
constexpr float ALPHA = 1.4142135623730951f;
constexpr float LN_EPS = 1e-5f;
constexpr float ATT_SCALE = 0.08838834764831845f;
constexpr int NWAVES = 8, NTHR = 512, BM_ = 256;
constexpr int UA_LD = 384;
constexpr int QKV0_LD = 6144, QKV1_LD = 12288;

constexpr size_t MiB = 1u << 20;
constexpr size_t WS_CTL = 0, CTL_ZERO_BYTES = 1 * MiB;
constexpr size_t WS_W_IN0 = 1 * MiB;
constexpr size_t WS_W_GLU = WS_W_IN0 + 64 * MiB;
constexpr size_t WS_W_OUT0 = WS_W_GLU + 8 * MiB;
constexpr size_t WS_W1_0 = WS_W_OUT0 + 32 * MiB;
constexpr size_t WS_W2_0 = WS_W1_0 + 128 * MiB;
constexpr size_t WS_W_IN1 = WS_W2_0 + 128 * MiB;
constexpr size_t WS_W_OUT1 = WS_W_IN1 + 98 * MiB;
constexpr size_t WS_W1_1 = WS_W_OUT1 + 32 * MiB;
constexpr size_t WS_W2_1 = WS_W1_1 + 128 * MiB;
constexpr size_t WS_BT2 = WS_W2_1 + 128 * MiB;
constexpr size_t WS_BT1 = WS_BT2 + 24 * MiB;
constexpr size_t WS_A16 = WS_BT1 + 16 * MiB;
constexpr size_t WS_FLOG = WS_A16 + 1 * MiB;
constexpr size_t WS_CB = WS_FLOG + 2 * MiB;
constexpr size_t WS_XB = WS_CB + 2 * MiB;
constexpr size_t WS_R = WS_XB + 128 * MiB;
constexpr size_t WS_UA = WS_R;
constexpr size_t WS_QKV0 = WS_UA + 96 * MiB;
constexpr size_t WS_XLOC = WS_QKV0 + 192 * MiB;
constexpr size_t WS_GACT = WS_XLOC + 64 * MiB;
constexpr size_t WS_CONCAT = WS_GACT + 64 * MiB;
constexpr size_t WS_HID = WS_R;
constexpr size_t WS_QKV1 = WS_R;
constexpr size_t WS_ATT = WS_R + 384 * MiB;
constexpr size_t WS_END = WS_R + 544 * MiB;
static_assert(WS_CONCAT + 128 * MiB == WS_END, "ws map");

constexpr int CW_BAR = 4096;
constexpr size_t WS_ST = 64 * 1024;
constexpr int ST_N = 16384;
static_assert(WS_ST + 6 * ST_N * 4 <= CTL_ZERO_BYTES, "s/t vectors inside the zeroed control region");
constexpr size_t WS_NRM = 512 * 1024;
constexpr size_t WS_DMIN = WS_NRM + 4096;
constexpr size_t WS_PS = WS_END;
constexpr size_t PS_STRIDE = (size_t)MTOK * 64;
constexpr size_t WS_SCR = WS_PS + 32 * MiB;
constexpr size_t WS_NEED = WS_SCR;

constexpr int RING_BYTES = 131072;
constexpr int MISC_OFF = RING_BYTES + 320;
constexpr int TBL_OFF = RING_BYTES + 1024;
constexpr int STB_OFF = RING_BYTES + 3072;
constexpr int KEY_WORD = 12;
constexpr int LDS_BYTES = 147456;

#define RLX_AGENT __ATOMIC_RELAXED, __HIP_MEMORY_SCOPE_AGENT
#define LDS_WAIT() asm volatile("s_waitcnt lgkmcnt(0)" ::: "memory")
#define VM_WAIT() asm volatile("s_waitcnt vmcnt(0)" ::: "memory")
__device__ __forceinline__ unsigned cvt_pk_bf16(float lo, float hi) { unsigned r; asm volatile("v_cvt_pk_bf16_f32 %0, %1, %2" : "=v"(r) : "v"(lo), "v"(hi)); return r; }
__device__ __forceinline__ unsigned f2bf(float f) { unsigned u = __builtin_bit_cast(unsigned, f); return (u + 0x7fffu + ((u >> 16) & 1u)) >> 16; }
__device__ __forceinline__ unsigned pk2(float lo, float hi) { return f2bf(lo) | (f2bf(hi) << 16); }
__device__ __forceinline__ float bf_lo(unsigned w) { return __builtin_bit_cast(float, w << 16); }
__device__ __forceinline__ float bf_hi(unsigned w) { return __builtin_bit_cast(float, w & 0xffff0000u); }
__device__ __forceinline__ u32x4 pack8f(f32x4 a, f32x4 b) { u32x4 w; w.x = cvt_pk_bf16(a[0], a[1]); w.y = cvt_pk_bf16(a[2], a[3]); w.z = cvt_pk_bf16(b[0], b[1]); w.w = cvt_pk_bf16(b[2], b[3]); return w; }
__device__ __forceinline__ int lane_id() { int l; asm volatile("v_mbcnt_lo_u32_b32 %0, -1, 0\n\tv_mbcnt_hi_u32_b32 %0, -1, %0" : "=v"(l)); return l; }
__device__ __forceinline__ float wave_sum(float v) {
#pragma unroll
    for (int o = 1; o < 64; o <<= 1) v += __shfl_xor(v, o);
    return v;
}
__device__ __forceinline__ float fast_exp(float x) { return __builtin_amdgcn_exp2f(x * 1.4426950408889634f); }
__device__ __forceinline__ float fast_sigmoid(float x) { return __builtin_amdgcn_rcpf(1.0f + fast_exp(-x)); }
__device__ __forceinline__ float gelu_tanh(float x) {
    const float a = 0.7978845608028654f * (x + 0.044715f * x * x * x);
    return x * fast_sigmoid(2.0f * a);
}

namespace pg8 {
constexpr int BM = 256, BK = 64, HALF = 128, HTB = HALF * BK * 2, STAGE_BYTES = 8 * HTB, NXCD = 8, WGM = 8;
__host__ __device__ __forceinline__ int lds_byte(int r, int c) { const int st = (r >> 4) * 2 + (c >> 5), rr = r & 15, cc = c & 31, ob = rr * 64 + cc * 2; return st * 1024 + (ob ^ (((ob >> 9) & 1) << 5)); }
__host__ __device__ __forceinline__ void stage_rc(int b, int& R, int& C) { const int st = b / 1024, sb = b % 1024, swz = sb ^ (((sb >> 9) & 1) << 5); R = (st >> 1) * 16 + swz / 64; C = (st & 1) * 32 + (swz % 64) / 2; }
__host__ __device__ __forceinline__ int perm32(int rho) { const int n = rho >> 4, i = rho & 15; return 8 * (i >> 2) + 4 * n + (i & 3); }

struct Unit { int pm, pn; };
struct Gemm { const bf16_t* A; const bf16_t* Bt; int lda, ldb, K; int kstepA = BK * 2; size_t tstepA = 0; int kstepB = BK * 2; size_t tstepB = 0; };

struct StaticOrder {
    int nM, nN, nwg, G, c;
    __host__ __device__ void init(int M, int N, int G_, int c_) { nM = M / BM; nN = N / BM; nwg = nM * nN; G = G_; c = c_; }
    __host__ __device__ bool next(int i, Unit& u) const {
        const long L = (long)i * G + c; if (L >= nwg) return false;
        int wgid = (int)L; { const int q = nwg / NXCD, r = nwg % NXCD, xcd = wgid % NXCD, off = wgid / NXCD; wgid = (xcd < r ? xcd * (q + 1) : r * (q + 1) + (xcd - r) * q) + off; }
        const int nig = WGM * nN, gid = wgid / nig, fm = gid * WGM, gsz = (nM - fm) < WGM ? (nM - fm) : WGM;
        u.pm = fm + ((wgid % nig) % gsz); u.pn = (wgid % nig) / gsz; return true;
    }
};
struct GroupOrder {
    int total, G, c;
    __host__ __device__ void init(int total_, int G_, int c_) { total = total_; G = G_; c = c_; }
    __host__ __device__ bool next(int i, Unit& u) const { const int L = i * G + c; if (L >= total) return false; u.pm = L; u.pn = L >> 2; return true; }
};

__device__ __forceinline__ float dpp_x1(float x) { return __builtin_bit_cast(float, __builtin_amdgcn_update_dpp(0, __builtin_bit_cast(int, x), 0xB1, 0xF, 0xF, false)); }
__device__ __forceinline__ f32x4 dpp_swap1(f32x4 v) { f32x4 r; r[0] = dpp_x1(v[0]); r[1] = dpp_x1(v[1]); r[2] = dpp_x1(v[2]); r[3] = dpp_x1(v[3]); return r; }
#define EPI_PIECES(...) \
    _Pragma("unroll") for (int ai = 0; ai < 2; ++ai) _Pragma("unroll") for (int m = 0; m < 4; ++m) { const int rl = ai * HALF + m * 16; \
        const f32x4 o0a = acc[ai][0][m][0], o0b = acc[ai][0][m][1], o1a = acc[ai][1][m][0], o1b = acc[ai][1][m][1]; \
        const f32x4 ra_ = dpp_swap1(odd ? o0a : o1a), rb_ = dpp_swap1(odd ? o0b : o1b); \
        const f32x4 p1a = odd ? ra_ : o0a, p1b = odd ? rb_ : o0b, p2a = odd ? o1a : ra_, p2b = odd ? o1b : rb_; __VA_ARGS__ \
        if (m & 1) asm volatile("" ::: "memory"); }
#define EPI_OPAQUE(x) asm volatile("" : "+v"(x))
struct EpiCtx { LAS unsigned char* lds; int tid, wid, lane; float pre; };

template <class Epi, class Sched, bool ALIGN_EPI>
__device__ __forceinline__ void gemm_phase(LAS unsigned char* lds, const Gemm g, const Sched& S, const Epi& E, const int wid) {
    const int lane = lane_id(), tid = wid * 64 + lane, wr = wid >> 2, wc = wid & 3, fr = lane & 15, fq = lane >> 4;
    const int K = g.K, nt = K / BK;
    unsigned voffA[2], voffB[2];
#pragma unroll
    for (int i = 0; i < 2; ++i) { int R, C; stage_rc(tid * 16 + i * 8192, R, C); const int Rb = (R >> 5) * 64 + perm32(R & 31);
        voffA[i] = (unsigned)(R * g.lda + C) * 2u; voffB[i] = (unsigned)(Rb * g.ldb + C) * 2u; }
    const size_t kstep = (size_t)g.kstepB, kstepA = (size_t)g.kstepA;
    const size_t hstepA = (size_t)HALF * g.lda * 2, hstepB = (size_t)32 * g.ldb * 2;
    const size_t tstepA = g.tstepA ? g.tstepA : 2 * hstepA, tstepB = g.tstepB ? g.tstepB : (size_t)BM * g.ldb * 2;
    const unsigned ldsw = (unsigned)wid * 1024u;
    const int aoff = lds_byte(wr * 64 + fr, fq * 8), boff = lds_byte(wc * 32 + fr, fq * 8);
#define PG8_SA(b, h) (((b) * 2 + (h)) * HTB)
#define PG8_SB(b, h) ((4 + (b) * 2 + (h)) * HTB)
#define PG8_STAGE(bufoff, gbase, voff) do { _Pragma("unroll") for (int _i = 0; _i < 2; ++_i) \
        __builtin_amdgcn_global_load_lds((const unsigned*)((const char*)(gbase) + (voff)[_i]), (LAS unsigned*)(lds + (bufoff) + ldsw + _i * 8192), 16, 0, 0); } while (0)
#define PG8_LDA(dst, b, h) do { _Pragma("unroll") for (int m = 0; m < 4; ++m) _Pragma("unroll") for (int k = 0; k < 2; ++k) dst[m][k] = *(const LAS bf16x8*)(lds + PG8_SA(b, h) + aoff + m * 2048 + k * 1024); } while (0)
#define PG8_LDB(dst, b, h) do { _Pragma("unroll") for (int n = 0; n < 2; ++n) _Pragma("unroll") for (int k = 0; k < 2; ++k) dst[n][k] = *(const LAS bf16x8*)(lds + PG8_SB(b, h) + boff + n * 2048 + k * 1024); } while (0)
#define PG8_MMA(ai, bj, At, Bt) do { __builtin_amdgcn_s_setprio(1); _Pragma("unroll") for (int m = 0; m < 4; ++m) _Pragma("unroll") for (int n = 0; n < 2; ++n) _Pragma("unroll") for (int k = 0; k < 2; ++k) \
        acc[ai][bj][m][n] = __builtin_amdgcn_mfma_f32_16x16x32_bf16(Bt[n][k], At[m][k], acc[ai][bj][m][n], 0, 0, 0); __builtin_amdgcn_s_setprio(0); } while (0)
#define PG8_WAIT_V(n) asm volatile("s_waitcnt vmcnt(" #n ")" ::: "memory")
#define PG8_WAIT_L(n) asm volatile("s_waitcnt lgkmcnt(" #n ")" ::: "memory")
#define PG8_BAR __builtin_amdgcn_s_barrier()
#define PG8_SCHED __builtin_amdgcn_sched_barrier(0)
    Unit cur, nxt; int ui = 0;
    if (!S.next(0, cur)) return;
    EpiCtx X; X.lds = lds; X.tid = tid; X.wid = wid; X.lane = lane; X.pre = 0.f;
    f32x4 acc[2][2][4][2];
#pragma unroll
    for (int a = 0; a < 2; ++a)
#pragma unroll
        for (int b = 0; b < 2; ++b)
#pragma unroll
            for (int m = 0; m < 4; ++m)
#pragma unroll
                for (int n = 0; n < 2; ++n) acc[a][b][m][n] = (f32x4){0.f, 0.f, 0.f, 0.f};
    bf16x8 At[4][2], B0[2][2], B1[2][2];
    const char* cA = (const char*)g.A + (size_t)cur.pm * tstepA; const char* cB = (const char*)g.Bt + (size_t)cur.pn * tstepB;
    PG8_STAGE(PG8_SB(0, 0), cB, voffB); PG8_STAGE(PG8_SB(0, 1), cB + hstepB, voffB); PG8_STAGE(PG8_SA(0, 0), cA, voffA); PG8_STAGE(PG8_SA(0, 1), cA + hstepA, voffA);
    if (wr == 1) PG8_BAR;
    PG8_WAIT_V(2); PG8_BAR;
    PG8_STAGE(PG8_SB(1, 0), cB + kstep, voffB); PG8_STAGE(PG8_SA(1, 0), cA + kstepA, voffA); PG8_STAGE(PG8_SB(1, 1), cB + hstepB + kstep, voffB);
    PG8_WAIT_V(6); PG8_BAR;
    for (;;) {
        const bool has_next = S.next(ui + 1, nxt);
        const char* nA = has_next ? (const char*)g.A + (size_t)nxt.pm * tstepA : cA; const char* nB = has_next ? (const char*)g.Bt + (size_t)nxt.pn * tstepB : cB;
#pragma nounroll
        for (int t = 0; t < nt; t += 2) {
            const bool last = (t == nt - 2);
            if constexpr (Epi::HAS_PRE) { if (last) X.pre = E.pre(cur, tid); }
            const char* a1 = cA + (size_t)(t + 1) * kstepA;
            const char* a2 = last ? nA : cA + (size_t)(t + 2) * kstepA; const char* b2 = last ? nB : cB + (size_t)(t + 2) * kstep;
            const char* a3 = a2 + kstepA; const char* b3 = b2 + kstep;
            PG8_LDB(B0, 0, 0); PG8_LDB(B1, 0, 1); PG8_SCHED; PG8_LDA(At, 0, 0); PG8_STAGE(PG8_SA(1, 1), a1 + hstepA, voffA);
            PG8_WAIT_V(8); PG8_WAIT_L(0); PG8_BAR; PG8_MMA(0, 0, At, B0); PG8_MMA(0, 1, At, B1); PG8_BAR; PG8_SCHED;
            PG8_LDA(At, 0, 1); PG8_STAGE(PG8_SB(0, 0), b2, voffB); PG8_STAGE(PG8_SB(0, 1), b2 + hstepB, voffB); PG8_STAGE(PG8_SA(0, 0), a2, voffA);
            PG8_WAIT_V(8); PG8_WAIT_L(0); PG8_BAR; PG8_MMA(1, 0, At, B0); PG8_MMA(1, 1, At, B1); PG8_BAR; PG8_SCHED;
            PG8_LDB(B0, 1, 0); PG8_LDB(B1, 1, 1); PG8_SCHED; PG8_LDA(At, 1, 0); PG8_STAGE(PG8_SA(0, 1), a2 + hstepA, voffA);
            PG8_WAIT_V(8); PG8_WAIT_L(0); PG8_BAR; PG8_MMA(0, 0, At, B0); PG8_MMA(0, 1, At, B1); PG8_BAR; PG8_SCHED;
            PG8_LDA(At, 1, 1); PG8_STAGE(PG8_SB(1, 0), b3, voffB); PG8_STAGE(PG8_SB(1, 1), b3 + hstepB, voffB); PG8_STAGE(PG8_SA(1, 0), a3, voffA);
            PG8_WAIT_V(8); PG8_WAIT_L(0); PG8_BAR; PG8_MMA(1, 0, At, B0); PG8_MMA(1, 1, At, B1); PG8_BAR; PG8_SCHED;
        }
        if constexpr (ALIGN_EPI) { if (wr == 0) PG8_BAR; }
        E(acc, cur, wr, wc, fr, fq, X);
        if (!has_next) break;
#pragma unroll
        for (int a = 0; a < 2; ++a)
#pragma unroll
            for (int b = 0; b < 2; ++b)
#pragma unroll
                for (int m = 0; m < 4; ++m)
#pragma unroll
                    for (int n = 0; n < 2; ++n) acc[a][b][m][n] = (f32x4){0.f, 0.f, 0.f, 0.f};
        cur = nxt; cA = nA; cB = nB; ++ui;
        if constexpr (ALIGN_EPI) { if (wr == 1) PG8_BAR; }
    }
    PG8_WAIT_V(0);
    if constexpr (!ALIGN_EPI) { if (wr == 0) PG8_BAR; }
    PG8_BAR;
#undef PG8_SA
#undef PG8_SB
#undef PG8_STAGE
#undef PG8_LDA
#undef PG8_LDB
#undef PG8_MMA
#undef PG8_WAIT_V
#undef PG8_WAIT_L
#undef PG8_BAR
#undef PG8_SCHED
}

struct EpiIn0 {
    static constexpr bool HAS_PRE = false;
    bf16_t* UA; bf16_t* QKV;
    __device__ __forceinline__ void operator()(const f32x4 (&acc)[2][2][4][2], const Unit& u, int wr, int wc, int fr, int fq, const EpiCtx& X) const {
        const bool odd = fr & 1; const int fe = fr - (fr & 1), o32 = (fr & 1) * 32;
        if (u.pn < 8) {
            char* base = (char*)(UA + ((size_t)u.pn * 16 * 1024 + (size_t)u.pm * 16) * UA_LD);
            unsigned lo = (unsigned)(((wc * 4 + (fr & 1) * 2 + (fq >> 1)) * 1024 + wr * 4) * UA_LD + fe * 16 + 8 * (fq & 1)) * 2u; EPI_OPAQUE(lo);
            EPI_PIECES({ const unsigned off = lo + (unsigned)((rl >> 4) * UA_LD) * 2u; *(u32x4*)(base + off) = pack8f(p1a, p1b); *(u32x4*)(base + off + 32) = pack8f(p2a, p2b); })
        } else {
            char* base = (char*)(QKV + (size_t)u.pm * BM * QKV0_LD + (u.pn * BM - W_SSM));
            unsigned lo = (unsigned)((wr * 64 + fe) * QKV0_LD + wc * 64 + o32 + 8 * fq) * 2u; EPI_OPAQUE(lo);
            EPI_PIECES({ const unsigned off = lo + (unsigned)(rl * QKV0_LD) * 2u; *(u32x4*)(base + off) = pack8f(p1a, p1b); *(u32x4*)(base + off + QKV0_LD * 2) = pack8f(p2a, p2b); })
        }
    }
};
struct EpiS1 {
    static constexpr bool HAS_PRE = false;
    float* XLOC;
    __device__ __forceinline__ void operator()(const f32x4 (&acc)[2][2][4][2], const Unit& u, int wr, int wc, int fr, int fq, const EpiCtx& X) const {
        const bool odd = fr & 1; const int fe = fr - (fr & 1), o32 = (fr & 1) * 32;
        char* base = (char*)(XLOC + (size_t)u.pm * BM * 128);
        unsigned lo = (unsigned)((wr * 64 + fe) * 128 + wc * 64 + o32 + 8 * fq) * 4u; EPI_OPAQUE(lo);
        EPI_PIECES({ if (wc < 2) { float* p = (float*)(base + (lo + (unsigned)(rl * 128) * 4u)); *(f32x4*)p = p1a; *(f32x4*)(p + 4) = p1b; *(f32x4*)(p + 128) = p2a; *(f32x4*)(p + 132) = p2b; } })
    }
};
struct EpiS2 {
    static constexpr bool HAS_PRE = false;
    const bf16_t* UA; const float* dvec; bf16_t* GACT;
    __device__ __forceinline__ void operator()(const f32x4 (&acc)[2][2][4][2], const Unit& u, int wr, int wc, int fr, int fq, const EpiCtx& X) const {
        const bool odd = fr & 1; const int fe = fr - (fr & 1), o32 = (fr & 1) * 32;
        const int g = u.pn; const int p0 = 8 * (fq & 1);
        const f32x4 d0 = *(const f32x4*)(dvec + g * 16 + p0), d1 = *(const f32x4*)(dvec + g * 16 + p0 + 4);
        const char* ub = (const char*)(UA + (size_t)u.pm * BM * UA_LD);
        unsigned ulo = (unsigned)((wr * 64 + fe) * UA_LD + wc * 64 + o32 + 8 * fq) * 2u; EPI_OPAQUE(ulo);
        char* gb = (char*)(GACT + (size_t)(u.pm & 3) * 256 * 16 * W_SSM + g * 16);
        unsigned glo = (unsigned)(((wr * 64 + fe) * 16 + wc * 4 + (fr & 1) * 2 + (fq >> 1)) * W_SSM + p0) * 2u; EPI_OPAQUE(glo);
#define S2_ONE(pa, pb, uoff, goff) do { const u32x4 uu = *(const u32x4*)(ub + (uoff)); f32x4 a, b; \
            a[0] = gelu_tanh(pa[0] + d0[0] * bf_lo(uu.x)); a[1] = gelu_tanh(pa[1] + d0[1] * bf_hi(uu.x)); a[2] = gelu_tanh(pa[2] + d0[2] * bf_lo(uu.y)); a[3] = gelu_tanh(pa[3] + d0[3] * bf_hi(uu.y)); \
            b[0] = gelu_tanh(pb[0] + d1[0] * bf_lo(uu.z)); b[1] = gelu_tanh(pb[1] + d1[1] * bf_hi(uu.z)); b[2] = gelu_tanh(pb[2] + d1[2] * bf_lo(uu.w)); b[3] = gelu_tanh(pb[3] + d1[3] * bf_hi(uu.w)); \
            *(u32x4*)(gb + (goff)) = pack8f(a, b); } while (0)
        EPI_PIECES({ const unsigned uoff = ulo + (unsigned)(rl * UA_LD) * 2u, goff = glo + (unsigned)(rl * 16 * W_SSM) * 2u;
            S2_ONE(p1a, p1b, uoff, goff); S2_ONE(p2a, p2b, uoff + UA_LD * 2, goff + 16 * W_SSM * 2); })
#undef S2_ONE
    }
};
struct EpiGlu {
    static constexpr bool HAS_PRE = false;
    const bf16_t* GACT; bf16_t* CC;
    __device__ __forceinline__ void operator()(const f32x4 (&acc)[2][2][4][2], const Unit& u, int wr, int wc, int fr, int fq, const EpiCtx& X) const {
        const bool odd = fr & 1; const int fe = fr - (fr & 1), o32 = (fr & 1) * 32;
        const char* gb = (const char*)(GACT + (size_t)u.pm * BM * W_SSM + u.pn * BM);
        unsigned glo = (unsigned)((wr * 64 + fe) * W_SSM + wc * 64 + o32 + 8 * fq) * 2u; EPI_OPAQUE(glo);
        char* cb = (char*)(CC + (size_t)u.pm * BM * DM + u.pn * BM);
        unsigned clo = (unsigned)((wr * 64 + fe) * DM + wc * 64 + o32 + 8 * fq) * 2u; EPI_OPAQUE(clo);
#define GLU_ONE(pa, pb, goff, coff) do { const u32x4 gg = *(const u32x4*)(gb + (goff)); f32x4 a, b; \
            a[0] = bf_lo(gg.x) * fast_sigmoid(pa[0]); a[1] = bf_hi(gg.x) * fast_sigmoid(pa[1]); a[2] = bf_lo(gg.y) * fast_sigmoid(pa[2]); a[3] = bf_hi(gg.y) * fast_sigmoid(pa[3]); \
            b[0] = bf_lo(gg.z) * fast_sigmoid(pb[0]); b[1] = bf_hi(gg.z) * fast_sigmoid(pb[1]); b[2] = bf_lo(gg.w) * fast_sigmoid(pb[2]); b[3] = bf_hi(gg.w) * fast_sigmoid(pb[3]); \
            *(u32x4*)(cb + (coff)) = pack8f(a, b); } while (0)
        EPI_PIECES({ const unsigned goff = glo + (unsigned)(rl * W_SSM) * 2u, coff = clo + (unsigned)(rl * DM) * 2u;
            GLU_ONE(p1a, p1b, goff, coff); GLU_ONE(p2a, p2b, goff + W_SSM * 2, coff + DM * 2); })
#undef GLU_ONE
    }
};
__device__ __forceinline__ void build_tbl(const f32x2* PS, int pm, LAS unsigned char* lds, int wid, int lane) {
    LAS f32x2* tbl = (LAS f32x2*)(lds + TBL_OFF);
    const f32x2* p = PS + ((size_t)pm * BM + wid * 32) * 64 + lane;
#pragma unroll 8
    for (int i = 0; i < 32; ++i) {
        const f32x2 v = p[(size_t)i * 64];
        const float a = wave_sum(v.x), b = wave_sum(v.y);
        if (lane == 0) { const float mu = a * (1.f / DM), var = fmaxf(b * (1.f / DM) - mu * mu, 0.f); tbl[wid * 32 + i] = (f32x2){mu, 1.f / sqrtf(var + LN_EPS)}; }
    }
}
__device__ __forceinline__ void ensure_tbl(const f32x2* PS, int sid, int pm, const EpiCtx& X) {
    volatile LAS unsigned* keyw = (volatile LAS unsigned*)(X.lds + MISC_OFF) + KEY_WORD;
    const unsigned key = (unsigned)(sid * 64 + pm + 1);
    if ((unsigned)__builtin_amdgcn_readfirstlane((int)keyw[0]) != key) {
        build_tbl(PS, pm, X.lds, X.wid, X.lane);
        asm volatile("s_waitcnt lgkmcnt(0)" ::: "memory"); __builtin_amdgcn_s_barrier(); asm volatile("" ::: "memory");
        if (X.tid == 0) keyw[0] = key;
    }
}
template <int RESM, bool OUTF> struct EpiResLN {
    static constexpr bool HAS_PRE = false;
    static constexpr bool RESN = RESM == 1;
    static_assert(RESM == 1 || RESM == 2, "the residual is always read from XB (bf16)");
    const float* res32; bf16_t* XB; float* Y32;
    const f32x2* PSp; int sidp; const float* gp; const float* bp;
    f32x2* PSn;
    __device__ __forceinline__ void operator()(const f32x4 (&acc)[2][2][4][2], const Unit& u, int wr, int wc, int fr, int fq, const EpiCtx& X) const {
        const bool odd = fr & 1; const int fe = fr - (fr & 1), o32 = (fr & 1) * 32;
        static_assert(!OUTF, "XB is K-tile-blocked; the f32 output path is not used");
        char* yb = nullptr; char* xb = (char*)(XB + (size_t)u.pm * BM * DM + (size_t)(u.pn * 4 + wc) * (BM * 64));
        unsigned lo = (unsigned)((wr * 64 + fe) * 64 + o32 + 8 * fq) * 2u; EPI_OPAQUE(lo);
        const int col = u.pn * BM + wc * 64 + o32 + 8 * fq;
        f32x4 g0, g1, b0, b1;
        if (RESN) { ensure_tbl(PSp, sidp, u.pm, X);
            g0 = *(const f32x4*)(gp + col); g1 = *(const f32x4*)(gp + col + 4); b0 = *(const f32x4*)(bp + col) * ALPHA; b1 = *(const f32x4*)(bp + col + 4) * ALPHA; }
        const LAS f32x2* tbl = (const LAS f32x2*)(X.lds + TBL_OFF) + wr * 64 + fe;
        f32x2* ps = PSn + ((size_t)u.pm * BM + wr * 64 + fe) * 64 + u.pn * 4 + wc;
#pragma unroll
        for (int ai = 0; ai < 2; ++ai) {
            u32x4 raw[8];
#pragma unroll
            for (int m = 0; m < 4; ++m) { const unsigned off = lo + (unsigned)((ai * HALF + m * 16) * 64) * 2u; raw[2 * m] = *(const u32x4*)(xb + off); raw[2 * m + 1] = *(const u32x4*)(xb + off + 128); }
#pragma unroll
            for (int m = 0; m < 4; ++m) {
                const int rl = ai * HALF + m * 16; const unsigned off = lo + (unsigned)(rl * 64) * 2u;
                const f32x4 o0a = acc[ai][0][m][0], o0b = acc[ai][0][m][1], o1a = acc[ai][1][m][0], o1b = acc[ai][1][m][1];
                const f32x4 ra_ = dpp_swap1(odd ? o0a : o1a), rb_ = dpp_swap1(odd ? o0b : o1b);
                const f32x4 pa[2] = {odd ? ra_ : o0a, odd ? o1a : ra_}, pb[2] = {odd ? rb_ : o0b, odd ? o1b : rb_};
#pragma unroll
                for (int q = 0; q < 2; ++q) {
                    const u32x4 w0 = raw[2 * m + q];
                    const f32x4 r0 = (f32x4){bf_lo(w0.x), bf_hi(w0.x), bf_lo(w0.y), bf_hi(w0.y)}, r1 = (f32x4){bf_lo(w0.z), bf_hi(w0.z), bf_lo(w0.w), bf_hi(w0.w)};
                    f32x4 y0, y1;
                    if (RESN) { const f32x2 t = tbl[rl + q]; const float mu = t.x, ra = t.y * ALPHA; y0 = (r0 - mu) * ra * g0 + b0 + pa[q]; y1 = (r1 - mu) * ra * g1 + b1 + pb[q]; }
                    else { y0 = r0 * ALPHA + pa[q]; y1 = r1 * ALPHA + pb[q]; }
                    { const u32x4 w = pack8f(y0, y1); *(u32x4*)(xb + off + q * 128) = w;
                        y0 = (f32x4){bf_lo(w.x), bf_hi(w.x), bf_lo(w.y), bf_hi(w.y)}; y1 = (f32x4){bf_lo(w.z), bf_hi(w.z), bf_lo(w.w), bf_hi(w.w)}; }
                    float sa = ((y0[0] + y0[1]) + (y0[2] + y0[3])) + ((y1[0] + y1[1]) + (y1[2] + y1[3]));
                    float sb = ((y0[0] * y0[0] + y0[1] * y0[1]) + (y0[2] * y0[2] + y0[3] * y0[3])) + ((y1[0] * y1[0] + y1[1] * y1[1]) + (y1[2] * y1[2] + y1[3] * y1[3]));
                    sa += dpp_x1(sa);
                    sb += dpp_x1(sb);
                    sa += __shfl_xor(sa, 16); sa += __shfl_xor(sa, 32); sb += __shfl_xor(sb, 16); sb += __shfl_xor(sb, 32);
                    if (fq == 0 && !odd) ps[(size_t)(rl + q) * 64] = (f32x2){sa, sb};
                }
            }
            asm volatile("" ::: "memory");
        }
    }
};
template <int ACT, int LDC, bool BLK = false> struct EpiLN {
    static constexpr bool HAS_PRE = true;
    bf16_t* O; const f32x2* PS; int sid; const float* sv; const float* tv;
    __device__ __forceinline__ float pre(const Unit& u, int tid) const { return (tid < 256 ? sv : tv)[u.pn * BM + (tid & 255)]; }
    __device__ __forceinline__ void operator()(const f32x4 (&acc)[2][2][4][2], const Unit& u, int wr, int wc, int fr, int fq, const EpiCtx& X) const {
        ensure_tbl(PS, sid, u.pm, X);
        LAS float* stb = (LAS float*)(X.lds + STB_OFF);
        stb[X.tid] = X.pre;
        asm volatile("s_waitcnt lgkmcnt(0)" ::: "memory"); __builtin_amdgcn_s_barrier(); asm volatile("" ::: "memory");
        const bool odd = fr & 1; const int fe = fr - (fr & 1), o32 = (fr & 1) * 32;
        constexpr int RP = BLK ? 64 : LDC;
        char* base = BLK ? (char*)(O + (size_t)u.pm * BM * LDC + (size_t)(u.pn * 4 + wc) * (BM * 64)) : (char*)(O + (size_t)u.pm * BM * LDC + u.pn * BM);
        unsigned lo = (unsigned)((wr * 64 + fe) * RP + (BLK ? 0 : wc * 64) + o32 + 8 * fq) * 2u; EPI_OPAQUE(lo);
        const LAS f32x2* tbl = (const LAS f32x2*)(X.lds + TBL_OFF) + wr * 64 + fe;
        const LAS f32x4* sp = (const LAS f32x4*)(stb + wc * 64 + o32 + 8 * fq);
        const f32x4 sa = sp[0], sb = sp[1], ta = sp[64], tb = sp[65];
#define LN_ONE(pa, pb, row_, off_) do { const f32x2 t = tbl[row_]; f32x4 a = ((pa) - sa * t.x) * t.y + ta, b = ((pb) - sb * t.x) * t.y + tb; \
            if (ACT == 1) { _Pragma("unroll") for (int e = 0; e < 4; ++e) { const float x = fmaxf(a[e], 0.f), y = fmaxf(b[e], 0.f); a[e] = x * x; b[e] = y * y; } } \
            if (BLK) __builtin_nontemporal_store(pack8f(a, b), (u32x4*)(base + (off_))); else *(u32x4*)(base + (off_)) = pack8f(a, b); } while (0)
        EPI_PIECES({ const unsigned off = lo + (unsigned)(rl * RP) * 2u; LN_ONE(p1a, p1b, rl, off); LN_ONE(p2a, p2b, rl + 1, off + RP * 2); })
#undef LN_ONE
    }
};
struct EpiIn1LN {
    static constexpr bool HAS_PRE = true;
    bf16_t* QKV; float* FLOGT; const f32x2* PS; int sid; const float* sv; const float* tv;
    __device__ __forceinline__ float pre(const Unit& u, int tid) const { return (tid < 256 ? sv : tv)[u.pn * BM + (tid & 255)]; }
    __device__ __forceinline__ void operator()(const f32x4 (&acc)[2][2][4][2], const Unit& u, int wr, int wc, int fr, int fq, const EpiCtx& X) const {
        if (u.pn < 48) { const EpiLN<0, QKV1_LD> E{QKV, PS, sid, sv, tv}; E(acc, u, wr, wc, fr, fq, X); }
        else {
            ensure_tbl(PS, sid, u.pm, X);
            LAS float* stb = (LAS float*)(X.lds + STB_OFF);
            stb[X.tid] = X.pre;
            asm volatile("s_waitcnt lgkmcnt(0)" ::: "memory"); __builtin_amdgcn_s_barrier(); asm volatile("" ::: "memory");
            if (wc == 0) {
                const int row0 = u.pm * BM + wr * 64 + fr;
                const LAS f32x2* tbl = (const LAS f32x2*)(X.lds + TBL_OFF) + wr * 64 + fr;
                const LAS f32x4* sp = (const LAS f32x4*)(stb + 8 * fq);
                const f32x4 sa = sp[0], sb = sp[1], ta = sp[64], tb = sp[65];
#pragma unroll
                for (int ai = 0; ai < 2; ++ai)
#pragma unroll
                    for (int m = 0; m < 4; ++m) {
                        const int row = row0 + ai * HALF + m * 16; const f32x2 t = tbl[ai * HALF + m * 16];
                        const f32x4 a = (acc[ai][0][m][0] - sa * t.x) * t.y + ta, b = (acc[ai][0][m][1] - sb * t.x) * t.y + tb;
                        float* d = FLOGT + ((size_t)(row >> 12) * FOX_H + 8 * fq) * SEQ + (row & (SEQ - 1));
#pragma unroll
                        for (int e = 0; e < 4; ++e) { d[(size_t)e * SEQ] = a[e]; d[(size_t)(4 + e) * SEQ] = b[e]; }
                    }
            }
        }
    }
};
}

namespace att {
constexpr int D = 128, NW = 8, QBLK = 32, KVBLK = 64, QB = 256;
constexpr int SHM_V = KVBLK * D * 2, SHM_K = KVBLK * D * 2;
constexpr int OFF_WS = 2 * SHM_V + 2 * SHM_K;
constexpr int OFF_FLAG = OFF_WS + NW * 64 * 4;
constexpr int OFF_CB = OFF_FLAG + 64;
constexpr int OFF_QL = OFF_CB + 4096 * 4;
constexpr int OFF_JUNK = OFF_QL + 8 * 4 * 1024;
constexpr int ATT_LDS = OFF_JUNK + 8 * 256;
static_assert(ATT_LDS <= RING_BYTES, "attention LDS");
#define KSWZ(row, colB) ((row) * 256 + ((colB) ^ (((row) & 7) << 4)))
#define SBAR() __builtin_amdgcn_sched_barrier(0)
#define LDS_BAR() do { asm volatile("s_waitcnt lgkmcnt(0)" ::: "memory"); __builtin_amdgcn_s_barrier(); asm volatile("" ::: "memory"); } while (0)
__device__ __forceinline__ int v_st(int k, int c) { const int kk = (k & ~0xC) | ((k & 4) << 1) | ((k & 8) >> 1); return ((kk >> 3) * 4 + (c >> 5)) * 512 + ((kk & 7) * 32 + (c & 31)) * 2; }
__device__ __forceinline__ int v_rd_base(int lane) { return ((lane & 3) << 3) | (((lane >> 2) & 3) << 6) | (((lane >> 4) & 1) << 5) | (((lane >> 5) & 1) << 8); }
constexpr int v_rd_off(int d0, int ks, int half) { return d0 * 512 + ks * 4096 + half * 2048; }
__device__ __forceinline__ int crow(int r, int hi) { return (r & 3) + 8 * (r >> 2) + 4 * hi; }
__device__ __forceinline__ bf16x8 load8(const bf16_t* p) { return *reinterpret_cast<const bf16x8*>(p); }

__device__ __forceinline__ void mask_tile(f32x16& p0, f32x16& p1, int dq, unsigned W) {
    const float NEG = -__builtin_inff();
#pragma unroll
    for (int r = 0; r < 16; ++r) {
        const int c = (r & 3) + 8 * (r >> 2);
        if ((unsigned)(dq - c) >= W) p0[r] = NEG;
        if ((unsigned)(dq - c - 32) >= W) p1[r] = NEG;
    }
}
constexpr float THR = 8.f;
__device__ __forceinline__ void partialSM(f32x16& p0, f32x16& p1, float& m_reg, float& mn, float& alpha) {
    float pmax = p0[0];
#pragma unroll
    for (int r = 1; r < 16; ++r) pmax = fmaxf(pmax, p0[r]);
#pragma unroll
    for (int r = 0; r < 16; ++r) pmax = fmaxf(pmax, p1[r]);
    { auto rr = __builtin_amdgcn_permlane32_swap(__float_as_uint(pmax), __float_as_uint(pmax), false, false);
      pmax = fmaxf(__uint_as_float(rr[0]), __uint_as_float(rr[1])); }
    constexpr float C2 = 1.4426950408889634f * ATT_SCALE;
    if (__builtin_expect(__all((pmax - m_reg) * ATT_SCALE <= THR), 1)) { mn = m_reg; alpha = 1.f; }
    else { mn = fmaxf(m_reg, pmax); alpha = __builtin_amdgcn_exp2f((m_reg - mn) * C2); m_reg = mn; }
    const float mnL = -mn * C2;
#pragma unroll
    for (int r = 0; r < 16; ++r) p0[r] = fmaf(p0[r], C2, mnL);
#pragma unroll
    for (int r = 0; r < 16; ++r) p1[r] = fmaf(p1[r], C2, mnL);
#pragma unroll
    for (int r = 0; r < 16; ++r) p0[r] = __builtin_amdgcn_exp2f(p0[r]);
}
#define PK4(P, B_, OUT) do { unsigned a0 = cvt_pk_bf16(P[B_+0], P[B_+1]), a1 = cvt_pk_bf16(P[B_+2], P[B_+3]);                          \
        unsigned b0 = cvt_pk_bf16(P[B_+4], P[B_+5]), b1 = cvt_pk_bf16(P[B_+6], P[B_+7]);                                             \
        auto r0 = __builtin_amdgcn_permlane32_swap(a0, b0, false, false); auto r1 = __builtin_amdgcn_permlane32_swap(a1, b1, false, false); \
        u32x4 w = {r0[0], r1[0], r0[1], r1[1]}; OUT = *reinterpret_cast<bf16x8*>(&w); } while (0)
__device__ __forceinline__ void finishSM(f32x16& p0, f32x16& p1, float alpha, float& l_reg, bf16x8& pa0, bf16x8& pa1, bf16x8& pa2, bf16x8& pa3) {
#pragma unroll
    for (int r = 0; r < 16; ++r) p1[r] = __builtin_amdgcn_exp2f(p1[r]);
    float ps = 0;
#pragma unroll
    for (int r = 0; r < 16; ++r) ps += p0[r];
#pragma unroll
    for (int r = 0; r < 16; ++r) ps += p1[r];
    { auto rr = __builtin_amdgcn_permlane32_swap(__float_as_uint(ps), __float_as_uint(ps), false, false);
      ps = __uint_as_float(rr[0]) + __uint_as_float(rr[1]); }
    l_reg = l_reg * alpha + ps;
    PK4(p0, 0, pa0); PK4(p0, 8, pa1); PK4(p1, 0, pa2); PK4(p1, 8, pa3);
}
template <int KB, bool BIAS, int QL = 0>
__device__ __forceinline__ void qkt(f32x16& p0, f32x16& p1, const char* K_lds, int r32, int hi, const bf16x8* qr, const float* cbt, const char* qlds = nullptr) {
    if constexpr (BIAS) {
#pragma unroll
        for (int g = 0; g < 4; ++g) { const f32x4 a = *(const f32x4*)(cbt + 8 * g), b = *(const f32x4*)(cbt + 32 + 8 * g);
#pragma unroll
            for (int e = 0; e < 4; ++e) { p0[4 * g + e] = a[e]; p1[4 * g + e] = b[e]; } }
    } else { p0 = f32x16{}; p1 = f32x16{}; }
    const char* kb[4];
#pragma unroll
    for (int dd = 0; dd < 4; ++dd) kb[dd] = K_lds + KB * SHM_K + KSWZ(r32, (dd * 16 + hi * 8) * 2);
#pragma unroll
    for (int d0 = 0; d0 < 8; ++d0) { const char* a = kb[d0 & 3] + (d0 >> 2) * 128;
        bf16x8 b0 = *reinterpret_cast<const bf16x8*>(a);
        bf16x8 b1 = *reinterpret_cast<const bf16x8*>(a + 32 * 256);
        bf16x8 q; if (d0 < 8 - QL) q = qr[d0]; else q = *reinterpret_cast<const bf16x8*>(qlds + (d0 - (8 - QL)) * 1024);
        p0 = __builtin_amdgcn_mfma_f32_32x32x16_bf16(b0, q, p0, 0, 0, 0);
        p1 = __builtin_amdgcn_mfma_f32_32x32x16_bf16(b1, q, p1, 0, 0, 0); }
}
template <int VB>
__device__ __forceinline__ void pv_tile(f32x16* o, int vb0, bf16x8 pa0, bf16x8 pa1, bf16x8 pa2, bf16x8 pa3) {
#define TRRD(dst, off) asm volatile("ds_read_b64_tr_b16 %0, %1 offset:%2" : "=&v"(dst) : "v"(vb0), "i"(off) : "memory")
#define PV_D0(d0) do { s16x4 l0, l1, l2, l3, h0, h1, h2, h3; constexpr int b_ = VB * SHM_V + v_rd_off(d0, 0, 0); \
        TRRD(l0, b_); TRRD(h0, b_ + 2048); TRRD(l1, b_ + 4096); TRRD(h1, b_ + 6144); TRRD(l2, b_ + 8192); TRRD(h2, b_ + 10240); TRRD(l3, b_ + 12288); TRRD(h3, b_ + 14336); \
        asm volatile("s_waitcnt lgkmcnt(0)" ::: "memory"); SBAR();   \
        o[d0] = __builtin_amdgcn_mfma_f32_32x32x16_bf16(pa0, (bf16x8){l0[0], l0[1], l0[2], l0[3], h0[0], h0[1], h0[2], h0[3]}, o[d0], 0, 0, 0);   \
        o[d0] = __builtin_amdgcn_mfma_f32_32x32x16_bf16(pa1, (bf16x8){l1[0], l1[1], l1[2], l1[3], h1[0], h1[1], h1[2], h1[3]}, o[d0], 0, 0, 0);   \
        o[d0] = __builtin_amdgcn_mfma_f32_32x32x16_bf16(pa2, (bf16x8){l2[0], l2[1], l2[2], l2[3], h2[0], h2[1], h2[2], h2[3]}, o[d0], 0, 0, 0);   \
        o[d0] = __builtin_amdgcn_mfma_f32_32x32x16_bf16(pa3, (bf16x8){l3[0], l3[1], l3[2], l3[3], h3[0], h3[1], h3[2], h3[3]}, o[d0], 0, 0, 0); } while (0)
    PV_D0(0); PV_D0(1); PV_D0(2); PV_D0(3);
#undef PV_D0
#undef TRRD
}

struct BlockRef { const bf16_t* Q; const bf16_t* K; const bf16_t* V; bf16_t* O; const float* CB; int P0; int bh; int jlo; };
struct Seam { bf16x8 qr[8]; bf16x8 st_v0, st_v1, st_k0, st_k1; };
constexpr int LDQ = QKV1_LD, LDO = DM;
#define GLD8(base, off32) (*(const bf16x8*)((const char*)(base) + (unsigned)(off32)))
#define VMW() asm volatile("s_waitcnt vmcnt(0)" ::: "memory")
#define VMWN(n) asm volatile("s_waitcnt vmcnt(%0)" :: "i"(n) : "memory")
#define SLOAD_H(Kp, Vp, k0) do { const char* kb__ = (const char*)(Kp) + (size_t)(k0) * (LDQ * 2); const char* vb__ = (const char*)(Vp) + (size_t)(k0) * (LDQ * 2); \
                         S.st_v0 = GLD8(vb__, loff); S.st_v1 = GLD8(vb__, loff + 32u * LDQ * 2u);              \
                         S.st_k0 = GLD8(kb__, loff); S.st_k1 = GLD8(kb__, loff + 32u * LDQ * 2u); } while (0)
#define SWRITE_HK(bf) do { *(bf16x8*)(K_lds + (bf) * SHM_K + kws) = S.st_k0; *(bf16x8*)(K_lds + (bf) * SHM_K + kws + 32 * 256) = S.st_k1; } while (0)
#define SWRITE_HV(bf) do { *(bf16x8*)(V_lds + (bf) * SHM_V + vst0) = S.st_v0; *(bf16x8*)(V_lds + (bf) * SHM_V + vst1) = S.st_v1; } while (0)
#define SWRITE_H(bf) do { SWRITE_HV(bf); SWRITE_HK(bf); } while (0)
__device__ __forceinline__ bool fox_item(int bx, int k, int G, int total, int& bh, int& y) {
    if (G == 256) { if (k >= 4) return false; const int x = bx & 7, c = bx >> 3, i = c & 7, sft = 4 * ((k + (i >> 1)) & 3);
        bh = 16 * x + (c >> 3) + 4 * k; y = ((i & 1) ? (0x6521 >> sft) : (0x7430 >> sft)) & 0xf; return true; }
    const int L = bx + k * G; if (L >= total) return false; bh = L >> 3; y = L & 7; return true;
}
__device__ __forceinline__ BlockRef fox_ref(int bh, int y, int pass, const bf16_t* QKV1, bf16_t* ATT, const float* CB, int jlo) {
    const int qb = pass ? 15 - y : y, b = bh >> 5, h = bh & 31;
    BlockRef r; const size_t tok0 = (size_t)b * SEQ;
    r.Q = QKV1 + (tok0 + qb * 256) * QKV1_LD + h * HD; r.K = QKV1 + tok0 * QKV1_LD + 4096 + h * HD; r.V = QKV1 + tok0 * QKV1_LD + 8192 + h * HD;
    r.O = ATT + (tok0 + qb * 256) * DM + h * HD; r.CB = CB + (size_t)bh * SEQ; r.P0 = qb * 256; r.bh = bh; r.jlo = jlo; return r;
}
__device__ __forceinline__ void fox_prime(const BlockRef& cur, char* lds, Seam& S, const int wid) {
    const int lane = lane_id(), tid = wid * 64 + lane, r32 = lane & 31, hi = lane >> 5;
    const int sr = tid >> 4, sc = (tid & 15) * 8, kws = KSWZ(sr, sc * 2); char* K_lds = lds + 2 * SHM_V;
    const unsigned loff = (unsigned)(sr * LDQ + sc) * 2u, qoff = (unsigned)((wid * QBLK + r32) * LDQ + hi * 8) * 2u;
#pragma unroll
    for (int d0 = 0; d0 < 8; ++d0) S.qr[d0] = GLD8(cur.Q, qoff + d0 * 32);
    SLOAD_H(cur.K, cur.V, cur.jlo * KVBLK); VMW(); SWRITE_HK(0);
    __syncthreads();
}
__device__ __forceinline__ void fox_block(const BlockRef& cur, const BlockRef& nxt, char* lds, Seam& S, int& bh_loaded, const int wid, const int jw, LAS unsigned char* ldsl) {
    const int lane = lane_id(), tid = wid * 64 + lane, r32 = lane & 31, hi = lane >> 5;
    const int NT = cur.P0 / KVBLK + 4 - cur.jlo;
    const unsigned W = 0x40000000u;
    const int qlo = cur.P0 + wid * QBLK, qm = qlo + r32 - 4 * hi;
    const int ta = jw - cur.jlo, tz = ((qlo + QBLK - 1) >> 6) - cur.jlo;
#define ACT(t) ((t) >= ta && (t) <= tz)
    char* V_lds = lds; char* K_lds = lds + 2 * SHM_V;
    float* ws = (float*)(lds + OFF_WS) + wid * 64; float* li_l = ws, * al_l = ws + 32;
    float* cb_l = (float*)(lds + OFF_CB);
    if (cur.bh != bh_loaded) {
#pragma unroll
        for (int i = 0; i < 2; ++i) ((f32x4*)cb_l)[tid + i * NTHR] = ((const f32x4*)cur.CB)[tid + i * NTHR];
        bh_loaded = cur.bh;
        __syncthreads();
    }
    const float* cbl = cb_l + 4 * hi;
    char* qlds = lds + OFF_QL + wid * 4096 + lane * 16;
#pragma unroll
    for (int f = 0; f < 4; ++f) *reinterpret_cast<bf16x8*>(qlds + f * 1024) = S.qr[4 + f];
    float m_reg = -1e30f, l_reg = 0; f32x16 o[4] = {};
    const int sr = tid >> 4, sc = (tid & 15) * 8, vst0 = v_st(sr, sc), vst1 = v_st(32 + sr, sc), kws = KSWZ(sr, sc * 2);
    const unsigned loff = (unsigned)(sr * LDQ + sc) * 2u, qoff = (unsigned)((wid * QBLK + r32) * LDQ + hi * 8) * 2u;
    const int vb0 = (int)(uintptr_t)V_lds + v_rd_base(lane);
    const bf16_t* Kh = cur.K; const bf16_t* Vh = cur.V;
#define RESC(a) do { if (__any((a) < 1.f)) { if (hi == 0) al_l[r32] = (a); asm volatile("s_waitcnt lgkmcnt(0)" ::: "memory");              \
                     _Pragma("unroll") for (int d_ = 0; d_ < 4; ++d_) _Pragma("unroll") for (int r = 0; r < 16; ++r) o[d_][r] *= al_l[crow(r, hi)]; } } while (0)
#define KBASE(t) ((cur.jlo + (t)) * KVBLK)
#define FOX_PF(tt_) do { const int t2_ = (tt_) < NT ? (tt_) : NT - 1, l_ = (wid << 5) | (lane >> 1);                              \
        const char* p_ = (const char*)((l_ & 2) ? Vh : Kh) + (size_t)(KBASE(t2_) + (l_ >> 2)) * (LDQ * 2) + (l_ & 1) * 128 + (lane & 1) * 64; \
        __builtin_amdgcn_global_load_lds((const unsigned*)p_, (LAS unsigned*)(ldsl + OFF_JUNK + wid * 256), 4, 0, 0); } while (0)
#define MASKT(P0_, P1_, t) do { const int kb_ = KBASE(t); if (kb_ + KVBLK - 1 > qlo) mask_tile(P0_, P1_, qm - kb_, W); } while (0)
    constexpr int NQL = 8;
#define SEAM_K0() do { VMWN(NQL); SWRITE_HK(0); SBAR(); } while (0)
    f32x16 pA0, pA1, pB0, pB1; float mnA, mnB, alA, alB; bf16x8 pa0, pa1, pa2, pa3;
    SWRITE_HV(0); SBAR();
    if (NT > 1) { SLOAD_H(Kh, Vh, KBASE(1)); }
    SBAR(); if (ACT(0)) { qkt<0, true, 4>(pA0, pA1, K_lds, r32, hi, S.qr, cbl + KBASE(0), qlds);
    MASKT(pA0, pA1, 0); partialSM(pA0, pA1, m_reg, mnA, alA); }
    if (NT > 1) { VMW(); SWRITE_H(1); }
    LDS_BAR();
#define HALF_STEP(PX0, PX1, mnX, alX, PY0, PY1, alY, t, KB, VB, SBF) do {                                                      \
        const bool ax_ = ACT(t), ay_ = ACT((t) - 1);                                                                          \
        SBAR(); if (ax_) qkt<KB, true, 4>(PX0, PX1, K_lds, r32, hi, S.qr, cbl + KBASE(t), qlds);                                    \
        if (ay_) finishSM(PY0, PY1, alY, l_reg, pa0, pa1, pa2, pa3); SBAR();                                                  \
        if ((t) + 1 < NT) { SLOAD_H(Kh, Vh, KBASE((t) + 1)); SBAR(); }                                               \
        if (ay_) pv_tile<VB>(o, vb0, pa0, pa1, pa2, pa3); if (ax_) { MASKT(PX0, PX1, (t)); partialSM(PX0, PX1, m_reg, mnX, alX); }                  \
        LDS_BAR();                                                                                                      \
        if ((t) + 1 < NT) { VMW(); SWRITE_H(SBF); }                                                                          \
        if (ax_) RESC(alX); LDS_BAR(); } while (0)
    for (int t = 1; t + 1 < NT; t += 2) {
        HALF_STEP(pB0, pB1, mnB, alB, pA0, pA1, alA, t, 1, 0, 0);
        HALF_STEP(pA0, pA1, mnA, alA, pB0, pB1, alB, t + 1, 0, 1, 1);
    }
    const bool even = (NT & 1) == 0;
    const bool actL = ACT(NT - 1), actA = even ? ACT(NT - 2) : actL;
    if (even) { SBAR(); if (actL) qkt<1, true, 4>(pB0, pB1, K_lds, r32, hi, S.qr, cbl + KBASE(NT - 1), qlds); SBAR(); }
    SLOAD_H(nxt.K, nxt.V, nxt.jlo * KVBLK); SBAR();
#pragma unroll
    for (int d0 = 0; d0 < 8; ++d0) S.qr[d0] = GLD8(nxt.Q, qoff + d0 * 32);
    SBAR();
    if (actA) { finishSM(pA0, pA1, alA, l_reg, pa0, pa1, pa2, pa3); SBAR();
    pv_tile<0>(o, vb0, pa0, pa1, pa2, pa3); }
    if (even) { if (actL) { MASKT(pB0, pB1, NT - 1); partialSM(pB0, pB1, m_reg, mnB, alB); } LDS_BAR(); if (actL) { RESC(alB);
        finishSM(pB0, pB1, alB, l_reg, pa0, pa1, pa2, pa3); SBAR(); pv_tile<1>(o, vb0, pa0, pa1, pa2, pa3); } }
    SBAR(); SEAM_K0();
    if (hi == 0) li_l[r32] = l_reg; asm volatile("s_waitcnt lgkmcnt(0)" ::: "memory");
    float rli[16];
#pragma unroll
    for (int r = 0; r < 16; ++r) rli[r] = __builtin_amdgcn_rcpf(li_l[crow(r, hi)]);
    const unsigned ooff = (unsigned)((wid * QBLK + 4 * hi) * LDO + r32) * 2u;
#pragma unroll
    for (int r = 0; r < 16; ++r) {
#pragma unroll
        for (int d0 = 0; d0 < 4; ++d0) { const float v = o[d0][r] * rli[r];
            const float vn = __shfl_xor(v, 1);
            if ((r32 & 1) == 0) *(unsigned*)((char*)cur.O + (ooff + (unsigned)((((r & 3) + 8 * (r >> 2)) * LDO + d0 * 32) * 2))) = cvt_pk_bf16(v, vn); } }
    LDS_BAR();
#undef RESC
#undef FOX_PF
#undef KBASE
#undef MASKT
#undef SEAM_K0
#undef HALF_STEP
#undef ACT
}
#undef SLOAD_H

constexpr int LDQ0 = QKV0_LD;
constexpr float SB_EXIT = 9.094947e-13f;
#ifndef SB_EARLY_EXIT
#define SB_EARLY_EXIT 1
#endif
__device__ __forceinline__ void sb_block(const bf16_t* Qb, const bf16_t* Kh, const bf16_t* Vh, bf16_t* Ob, int P0, char* lds, LAS unsigned char* ldsl, const int wid) {
    const int lane = lane_id(), tid = wid * 64 + lane, r32 = lane & 31, hi = lane >> 5;
    char* V_lds = lds; char* K_lds = lds + 2 * SHM_V;
    volatile LAS int* flags = (volatile LAS int*)(ldsl + OFF_FLAG);
    const int sr = tid >> 4, sc = (tid & 15) * 8, vst0 = v_st(sr, sc), vst1 = v_st(32 + sr, sc), kws = KSWZ(sr, sc * 2);
    const int vb0 = (int)(uintptr_t)V_lds + v_rd_base(lane);
    const int qlo = P0 + wid * QBLK, qrow = qlo + r32;
    bf16x8 qr[8];
    const unsigned loff = (unsigned)(sr * LDQ0 + sc) * 2u, qoff = (unsigned)((wid * QBLK + r32) * LDQ0 + hi * 8) * 2u;
#pragma unroll
    for (int d0 = 0; d0 < 8; ++d0) qr[d0] = GLD8(Qb, qoff + d0 * 32);
    f32x16 o[4] = {};
    float R = 1.f; bool wdone = false;
    const int NT = P0 / KVBLK + 4;
    bf16x8 st_v0, st_v1, st_k0, st_k1;
#define SB_LOAD(kk0) do { const char* kb__ = (const char*)Kh + (size_t)(kk0) * (LDQ0 * 2); const char* vb__ = (const char*)Vh + (size_t)(kk0) * (LDQ0 * 2); \
                         st_v0 = GLD8(vb__, loff); st_v1 = GLD8(vb__, loff + 32u * LDQ0 * 2u); st_k0 = GLD8(kb__, loff); st_k1 = GLD8(kb__, loff + 32u * LDQ0 * 2u); } while (0)
    SB_LOAD((NT - 1) * KVBLK);
    for (int t = NT - 1; t >= 0; --t) {
        VMW();
        *(bf16x8*)(V_lds + vst0) = st_v0; *(bf16x8*)(V_lds + vst1) = st_v1;
        *(bf16x8*)(K_lds + kws) = st_k0; *(bf16x8*)(K_lds + kws + 32 * 256) = st_k1;
        if (t > 0) SB_LOAD((t - 1) * KVBLK);
        LDS_BAR();
        const int kb = t * KVBLK;
        if (kb <= qlo && !wdone) {
            f32x16 p0, p1;
            qkt<0, false>(p0, p1, K_lds, r32, hi, qr, nullptr);
            f32x16 kp0, kp1;
            const int dq = qrow - kb - 4 * hi;
            const float NEGINF = -__builtin_inff();
            constexpr float CZ = ATT_SCALE * 1.4426950408889634f;
#pragma unroll
            for (int r = 0; r < 16; ++r) {
                const int c = (r & 3) + 8 * (r >> 2);
                const float z0 = (c < dq) ? p0[r] * CZ : NEGINF, z1 = (c + 32 < dq) ? p1[r] * CZ : NEGINF;
                const float e0 = __builtin_amdgcn_exp2f(-fabsf(z0)), e1 = __builtin_amdgcn_exp2f(-fabsf(z1));
                const float i0 = __builtin_amdgcn_rcpf(1.0f + e0), i1 = __builtin_amdgcn_rcpf(1.0f + e1);
                const float f0 = e0 * i0, f1 = e1 * i1;
                p0[r] = (z0 < 0.f) ? f0 : i0; kp0[r] = (z0 < 0.f) ? i0 : f0;
                p1[r] = (z1 < 0.f) ? f1 : i1; kp1[r] = (z1 < 0.f) ? i1 : f1;
            }
            float glo[2][4], ghi[2][4];
#pragma unroll
            for (int g = 0; g < 4; ++g) {
                const float t0 = (kp0[4 * g] * kp0[4 * g + 1]) * (kp0[4 * g + 2] * kp0[4 * g + 3]);
                const float t1 = (kp1[4 * g] * kp1[4 * g + 1]) * (kp1[4 * g + 2] * kp1[4 * g + 3]);
                auto r0 = __builtin_amdgcn_permlane32_swap(__float_as_uint(t0), __float_as_uint(t0), false, false);
                auto r1 = __builtin_amdgcn_permlane32_swap(__float_as_uint(t1), __float_as_uint(t1), false, false);
                glo[0][g] = __uint_as_float(r0[0]); ghi[0][g] = __uint_as_float(r0[1]);
                glo[1][g] = __uint_as_float(r1[0]); ghi[1][g] = __uint_as_float(r1[1]);
            }
            float A = R; float off[2][4];
#pragma unroll
            for (int blk = 1; blk >= 0; --blk)
#pragma unroll
                for (int g = 3; g >= 0; --g) { const float oh = A; A *= ghi[blk][g]; const float ol = A; A *= glo[blk][g]; off[blk][g] = hi ? oh : ol; }
            R = A;
#pragma unroll
            for (int g = 0; g < 4; ++g) {
                float s0 = off[0][g], s1 = off[1][g];
#pragma unroll
                for (int e = 3; e >= 0; --e) {
                    const int r = 4 * g + e;
                    const float w0 = p0[r] * s0, w1 = p1[r] * s1;
                    s0 *= kp0[r]; s1 *= kp1[r];
                    p0[r] = w0; p1[r] = w1;
                }
            }
            bf16x8 pa0, pa1, pa2, pa3;
            PK4(p0, 0, pa0); PK4(p0, 8, pa1); PK4(p1, 0, pa2); PK4(p1, 8, pa3);
            pv_tile<0>(o, vb0, pa0, pa1, pa2, pa3);
            wdone = SB_EARLY_EXIT && __all(R < SB_EXIT);
        }
        if (SB_EARLY_EXIT) { if (lane == 0) flags[wid] = wdone ? 1 : 0; }
        LDS_BAR();
        if (SB_EARLY_EXIT) {
            int all = 1;
#pragma unroll
            for (int w = 0; w < NW; ++w) all &= flags[w];
            if (all) break;
        }
    }
#undef SB_LOAD
    const unsigned ooff = (unsigned)((wid * QBLK + 4 * hi) * LDO + r32) * 2u;
#pragma unroll
    for (int r = 0; r < 16; ++r) {
#pragma unroll
        for (int d0 = 0; d0 < 4; ++d0) { const float v = o[d0][r];
            const float vn = __shfl_xor(v, 1);
            if ((r32 & 1) == 0) *(unsigned*)((char*)Ob + (ooff + (unsigned)((((r & 3) + 8 * (r >> 2)) * LDO + d0 * 32) * 2))) = cvt_pk_bf16(v, vn); } }
    VMW();
    LDS_BAR();
}
#undef GLD8
#undef VMW
#undef VMWN
#undef SWRITE_HK
#undef SWRITE_HV
#undef SWRITE_H
#undef PK4
}

#define XB_TMO      128
#define XB_XCNT(j)  (256  + 64 * (j))
#define XB_XSUB(j)  (1280 + 64 * (j))
#define XB_XGEN(j)  (2304 + 64 * (j))
#define XB_TOP      3328
#define XB_TOPGEN   3392
#define XCD_BAR_WORDS 3456
#define XB_SPIN_CAP (1u << 18)
__device__ __forceinline__ unsigned xb_ld(unsigned* p)              { return __hip_atomic_load(p, __ATOMIC_RELAXED, __HIP_MEMORY_SCOPE_AGENT); }
__device__ __forceinline__ unsigned xb_add(unsigned* p, unsigned v) { return __hip_atomic_fetch_add(p, v, __ATOMIC_RELAXED, __HIP_MEMORY_SCOPE_AGENT); }
__device__ __forceinline__ unsigned xb_xcc_id() { return (unsigned)__builtin_amdgcn_s_getreg((3 << 11) | 20) & 0xFu; }
#define XB_SPIN(cond, bar) do { unsigned _sp = 0; while (cond) { __builtin_amdgcn_s_sleep(1); \
    if ((++_sp & 255u) == 0u) { if (xb_ld(&(bar)[XB_TMO])) break; if (_sp > XB_SPIN_CAP) { atomicAdd(&(bar)[XB_TMO], 1u); break; } } } } while (0)
struct XcdBarrier { unsigned* bar; unsigned x; volatile LAS unsigned* st; };
__device__ __forceinline__ XcdBarrier xcd_barrier_post(unsigned* bar, volatile LAS unsigned* st, const bool t0) {
    XcdBarrier b; b.bar = bar; b.x = xb_xcc_id(); b.st = st;
    if (t0) (void)xb_add(&bar[XB_XCNT(b.x)], 1u);
    return b;
}
__device__ __forceinline__ void xcd_barrier_complete(unsigned* bar, unsigned x, unsigned& nloc, unsigned& nx) {
    const unsigned G = gridDim.x * gridDim.y * gridDim.z;
    unsigned sum, cnt, mine, sp = 0u;
    for (;;) {
        sum = 0u; cnt = 0u; mine = 0u;
#pragma unroll
        for (unsigned j = 0; j < 16; ++j) { const unsigned c = xb_ld(&bar[XB_XCNT(j)]); sum += c; cnt += (c > 0u) ? 1u : 0u; mine = (j == x) ? c : mine; }
        if (sum == G) break;
        __builtin_amdgcn_s_sleep(1);
        if ((++sp & 255u) == 0u) { if (xb_ld(&bar[XB_TMO])) break; if (sp > XB_SPIN_CAP) { atomicAdd(&bar[XB_TMO], 1u); break; } }
    }
    nloc = mine > 0u ? mine : 1u; nx = cnt > 0u ? cnt : 1u;
}
__device__ __forceinline__ void xcd_barrier(const XcdBarrier& b, const bool t0) {
    asm volatile("s_waitcnt vmcnt(0)" ::: "memory");
    __syncthreads();
    if (t0) {
        unsigned* bar = b.bar;
        __builtin_amdgcn_s_waitcnt(0);
        unsigned nloc = b.st[0], nx = b.st[1];
        if (nloc == 0u) { xcd_barrier_complete(bar, b.x, nloc, nx); b.st[0] = nloc; b.st[1] = nx; }
        const unsigned old = xb_add(&bar[XB_XSUB(b.x)], 1u);
        const unsigned gen = old / nloc;
        if (old + 1u == (gen + 1u) * nloc) {
            __builtin_amdgcn_fence(__ATOMIC_RELEASE, "agent");
            asm volatile("s_waitcnt vmcnt(0)" ::: "memory");
            const unsigned og = xb_add(&bar[XB_TOP], 1u);
            const unsigned tg = og / nx;
            if (og + 1u == (tg + 1u) * nx) xb_add(&bar[XB_TOPGEN], 1u);
            else XB_SPIN(xb_ld(&bar[XB_TOPGEN]) == tg, bar);
            __builtin_amdgcn_fence(__ATOMIC_ACQUIRE, "agent");
            xb_add(&bar[XB_XGEN(b.x)], 1u);
            asm volatile("s_waitcnt vmcnt(0)" ::: "memory");
        } else {
            XB_SPIN(xb_ld(&bar[XB_XGEN(b.x)]) == gen, bar);
            __builtin_amdgcn_fence(__ATOMIC_ACQUIRE, "agent");
            asm volatile("s_waitcnt vmcnt(0)" ::: "memory");
        }
    }
    __syncthreads();
}

__device__ __forceinline__ void transpose_item(const float* W, int K, int N, bf16_t* WT, LAS float* scr, int item, int lane, const float* gam, const float* bet, float* sdst) {
    const int nblk = N / 32, nbg = (nblk + 7) >> 3, g64 = item >> 6, r = item & 63;
    const int nb = (g64 % nbg) * 8 + (r & 7), kb = (g64 / nbg) * 8 + (r >> 3), k0 = 64 * kb, n0 = 32 * nb;
    if (nb >= nblk) return;
#pragma unroll
    for (int i = 0; i < 8; ++i) { const int kk = 8 * i + (lane >> 3), n4 = (lane & 7) * 4;
        const f32x4 w = *(const f32x4*)(W + (size_t)(k0 + kk) * N + n0 + n4); LAS float* d = scr + kk * 33 + n4; d[0] = w[0]; d[1] = w[1]; d[2] = w[2]; d[3] = w[3]; }
    if (gam) { scr[64 * 33 + lane] = gam[k0 + lane]; scr[64 * 33 + 64 + lane] = bet[k0 + lane]; }
    LDS_WAIT(); asm volatile("" ::: "memory");
    if (gam) {
        const int n = lane & 31, h = lane >> 5; float sa = 0.f, ta = 0.f;
#pragma unroll 8
        for (int i = 0; i < 32; ++i) { const int kk = h * 32 + i; const float w = scr[kk * 33 + n]; const float wg = w * scr[64 * 33 + kk];
            scr[kk * 33 + n] = wg; sa += bf_lo(f2bf(wg)); ta += w * scr[64 * 33 + 64 + kk]; }
        sa += __shfl_xor(sa, 32); ta += __shfl_xor(ta, 32);
        if (lane < 32) { unsafeAtomicAdd(sdst + n0 + lane, sa); unsafeAtomicAdd(sdst + ST_N + n0 + lane, ta); }
        LDS_WAIT(); asm volatile("" ::: "memory");
    }
    const int c = lane & 7;
#pragma unroll
    for (int j = 0; j < 4; ++j) { const int n = (lane >> 3) + 8 * j; const LAS float* s = scr + (8 * c) * 33 + n;
        u32x4 o; o.x = pk2(s[0 * 33], s[1 * 33]); o.y = pk2(s[2 * 33], s[3 * 33]); o.z = pk2(s[4 * 33], s[5 * 33]); o.w = pk2(s[6 * 33], s[7 * 33]);
        *(GAS u32x4*)(WT + (size_t)((n0 + n) >> 8) * ((size_t)K * 256) + (size_t)kb * (256 * 64) + ((n0 + n) & 255) * 64 + 8 * c) = o; }
    LDS_WAIT(); asm volatile("" ::: "memory");
}

struct Args {
    const float* in[21]; float* out; unsigned char* ws; int ph_lo, ph_hi;
};

__device__ __forceinline__ void ln_phase(const float* Yin, float* Y, bf16_t* XB, const float* gam, const float* bet, LAS unsigned char* lds, int gw, int NGW, int tid, int lane) {
    LAS f32x4* gl = (LAS f32x4*)lds; LAS f32x4* bl = (LAS f32x4*)(lds + 16384);
    for (int i = tid; i < 1024; i += NTHR) { gl[i] = ((const f32x4*)gam)[i]; bl[i] = ((const f32x4*)bet)[i]; }
    __syncthreads();
    for (int row = gw; row < MTOK; row += NGW) {
        f32x4* yr = (f32x4*)(Y + (size_t)row * DM) + lane; const f32x4* yi = (const f32x4*)(Yin + (size_t)row * DM) + lane;
        f32x4 v[16]; float s = 0.f;
#pragma unroll
        for (int j = 0; j < 16; ++j) { v[j] = yi[64 * j]; s += (v[j][0] + v[j][1]) + (v[j][2] + v[j][3]); }
        const float mean = wave_sum(s) * (1.f / DM); float s2 = 0.f;
#pragma unroll
        for (int j = 0; j < 16; ++j) { v[j] = v[j] - mean; s2 += (v[j][0] * v[j][0] + v[j][1] * v[j][1]) + (v[j][2] * v[j][2] + v[j][3] * v[j][3]); }
        const float rstd = 1.f / sqrtf(wave_sum(s2) * (1.f / DM) + LN_EPS);
        u32x2* xo = (u32x2*)(XB + (size_t)row * DM) + lane;
#pragma unroll
        for (int j = 0; j < 16; ++j) { const f32x4 o = v[j] * rstd * gl[64 * j + lane] + bl[64 * j + lane]; yr[64 * j] = o;
            u32x2 w; w.x = cvt_pk_bf16(o[0], o[1]); w.y = cvt_pk_bf16(o[2], o[3]); xo[64 * j] = w; }
    }
    __syncthreads();
}

__device__ __forceinline__ void ln_final(const bf16_t* XB, float* Y, const f32x2* PS, const float* gam, const float* bet, LAS unsigned char* lds, int gw, int NGW, int wave) {
    LAS f32x4* gl = (LAS f32x4*)lds; LAS f32x4* bl = (LAS f32x4*)(lds + 16384);
    { const int t0 = wave * 64 + lane_id(); gl[t0] = ((const f32x4*)gam)[t0]; bl[t0] = ((const f32x4*)bet)[t0]; gl[t0 + 512] = ((const f32x4*)gam)[t0 + 512]; bl[t0 + 512] = ((const f32x4*)bet)[t0 + 512]; }
    __syncthreads();
    for (int row = gw; row < MTOK; row += NGW) {
        const int lane = lane_id();
        char* yb = (char*)(Y + (size_t)row * DM); const char* xb = (const char*)(XB + (size_t)(row >> 8) * (BM_ * DM) + (row & 255) * 64);
        const unsigned lo16 = (unsigned)((lane >> 3) * (BM_ * 64) + (lane & 7) * 8) * 2u, lo32 = (unsigned)lane * 32u;
        float mu, rr; { const f32x2 pv = PS[(size_t)row * 64 + lane]; const float a = wave_sum(pv.x), b = wave_sum(pv.y); mu = a * (1.f / DM); rr = 1.f / sqrtf(fmaxf(b * (1.f / DM) - mu * mu, 0.f) + LN_EPS); }
        asm volatile("" ::: "memory");
        u32x4 v[8];
#pragma unroll
        for (int j = 0; j < 8; ++j) v[j] = *(const u32x4*)(xb + (lo16 + j * (8 * BM_ * 64 * 2)));
#pragma unroll
        for (int j = 0; j < 8; ++j) { const int q = (64 * j + lane) * 2;
            const f32x4 a = (f32x4){bf_lo(v[j].x), bf_hi(v[j].x), bf_lo(v[j].y), bf_hi(v[j].y)}, b = (f32x4){bf_lo(v[j].z), bf_hi(v[j].z), bf_lo(v[j].w), bf_hi(v[j].w)};
            *(f32x4*)(yb + (lo32 + j * 2048)) = (a - mu) * rr * gl[q] + bl[q]; *(f32x4*)(yb + (lo32 + j * 2048 + 16)) = (b - mu) * rr * gl[q + 1] + bl[q + 1]; }
    }
    __syncthreads();
}

constexpr int N_PHASES = 19;
static_assert(sizeof(Args) == 192, "Args layout: in[21] @0, out @168, ws @176, ph_lo @184, ph_hi @188");
__global__ void __launch_bounds__(NTHR, 2) mega_fwd(Args) {
    extern __shared__ __attribute__((aligned(16))) unsigned char lds_raw[];
    LAS unsigned char* lds = (LAS unsigned char*)lds_raw;
    volatile LAS unsigned* MISC = (volatile LAS unsigned*)(lds + MISC_OFF);
    const int wave = __builtin_amdgcn_readfirstlane((int)threadIdx.x >> 6);
#define TIDLANE() const int lane = lane_id(); const int tid = wave * 64 + lane; (void)tid
    const int G = gridDim.x, bx = blockIdx.x;
    const int gw = bx * NWAVES + wave, NGW = G * NWAVES;
    { TIDLANE(); for (int u = tid; u < (LDS_BYTES - RING_BYTES) / 4; u += NTHR) ((LAS unsigned*)(lds + RING_BYTES))[u] = 0u; }
    __syncthreads();
#define WSBASE() const AS4 unsigned char* kp_ = (const AS4 unsigned char*)__builtin_amdgcn_kernarg_segment_ptr(); asm volatile("" : "+s"(kp_)); \
                 unsigned char* wsb = *(unsigned char* const AS4*)(kp_ + 176); float* outp = *(float* const AS4*)(kp_ + 168); (void)outp; (void)wsb
#define WSP(T, off) ((T*)(wsb + (off)))
#define INP(k) (*(const float* const AS4*)(kp_ + 8 * (k)))
#if MK_ONE_LAUNCH
    { WSBASE(); (void)xcd_barrier_post((unsigned*)(wsb + WS_CTL) + CW_BAR, MISC + 8, wave == 0 && lane_id() == 0); }
#define GRID_BAR() do { WSBASE(); XcdBarrier bar_; bar_.bar = (unsigned*)(wsb + WS_CTL) + CW_BAR; bar_.x = xb_xcc_id(); bar_.st = MISC + 8; xcd_barrier(bar_, wave == 0 && lane_id() == 0); } while (0)
#else
#define GRID_BAR() do {} while (0)
#endif
    int lo, hi; { const AS4 int* kq = (const AS4 int*)__builtin_amdgcn_kernarg_segment_ptr(); lo = kq[46]; hi = kq[47]; }
#ifndef PH_MASK
#define PH_MASK 0x7FFFF
#endif
#define IN(k) (((PH_MASK >> (k)) & 1) && lo <= (k) && (k) < hi)
#define BOTH(k) (IN(k) && IN((k) + 1))
#ifndef PROBE_REP
#define PROBE_REP -1
#endif
#define NREP(k) ((PROBE_REP) == (k) ? 2 : 1)
#define PSCR(k) ((PROBE_REP) == (k) && rep_ == 0)

    for (int rep_ = 0; rep_ < NREP(0); ++rep_) if (IN(0)) {
        WSBASE(); TIDLANE();
        {
            const float* a_re = INP(2); const float* a_im = INP(3); const float* log_dt = INP(4);
            const float* b_re = INP(5); const float* b_im = INP(6); const float* c_re = INP(7); const float* c_im = INP(8);
            bf16_t* BT2 = WSP(bf16_t, WS_BT2); bf16_t* BT1 = WSP(bf16_t, WS_BT1); f32x2* A16 = WSP(f32x2, WS_A16);
            LAS f32x2* pw = (LAS f32x2*)lds;
            LAS f32x2* bb = (LAS f32x2*)(lds + 16384);
            LAS f32x2* cc = (LAS f32x2*)(lds + 32768);
            LAS float* Kt = (LAS float*)(lds + 49152);
            for (int g = bx; g < SSM_G; g += G) {
                if (tid < 64) {
                    const int n = tid;
                    const double lr = (double)a_re[g * 64 + n], li = (double)a_im[g * 64 + n], dt = exp((double)log_dt[g]);
                    const double mag = exp(lr * dt); double sn, cs; sincos(li * dt, &sn, &cs);
                    const double ar = mag * cs, ai = mag * sn;
                    const double den = lr * lr + li * li, nr = ar - 1.0, ni = ai;
                    const double zr = (nr * lr + ni * li) / den, zi = (ni * lr - nr * li) / den;
                    double pr = 1.0, pi = 0.0;
                    pw[n] = (f32x2){1.f, 0.f};
                    for (int tau = 1; tau <= 16; ++tau) { const double t0 = pr * ar - pi * ai, t1 = pr * ai + pi * ar; pr = t0; pi = t1; pw[tau * 64 + n] = (f32x2){(float)pr, (float)pi}; }
                    A16[g * 64 + n] = (f32x2){(float)pr, (float)pi};
                    for (int q = 0; q < 16; ++q) { const double br = (double)b_re[(size_t)(g * 64 + n) * 16 + q], bi = (double)b_im[(size_t)(g * 64 + n) * 16 + q];
                        bb[n * 16 + q] = (f32x2){(float)(zr * br - zi * bi), (float)(zr * bi + zi * br)}; }
                }
                for (int i = tid; i < 1024; i += NTHR) cc[i] = (f32x2){c_re[(size_t)g * 1024 + i], c_im[(size_t)g * 1024 + i]};
                __syncthreads();
                for (int idx = tid; idx < 4096; idx += NTHR) {
                    const int tau = idx >> 8, p = (idx >> 4) & 15, q = idx & 15; float acc = 0.f;
                    for (int n = 0; n < 64; ++n) { const f32x2 c = cc[p * 64 + n], a = pw[tau * 64 + n], b = bb[n * 16 + q];
                        const float cr = c.x * a.x - c.y * a.y, ci = c.x * a.y + c.y * a.x; acc += cr * b.x - ci * b.y; }
                    Kt[idx] = acc;
                }
                __syncthreads();
                for (int idx = tid; idx < 256 * 384; idx += NTHR) {
                    const int r = idx / 384, cidx = idx % 384, t = r >> 4, p = r & 15; float v;
                    if (cidx < 256) { const int s_ = cidx >> 4, q = cidx & 15; v = (s_ <= t) ? Kt[((t - s_) << 8) + (p << 4) + q] : 0.f; }
                    else { const int j = cidx - 256, n = j & 63; const f32x2 c = cc[p * 64 + n], a = pw[(t + 1) * 64 + n];
                        v = (j < 64) ? (c.x * a.x - c.y * a.y) : -(c.x * a.y + c.y * a.x); }
                    BT2[(size_t)g * 256 * 384 + idx] = (bf16_t)f2bf(v);
                }
                for (int idx = tid; idx < 256 * 256; idx += NTHR) {
                    const int j = idx >> 8, cidx = idx & 255, s_ = cidx >> 4, q = cidx & 15; float v = 0.f;
                    if (j < 128) { const int n = j & 63; const f32x2 a = pw[(15 - s_) * 64 + n], b = bb[n * 16 + q];
                        v = (j < 64) ? (a.x * b.x - a.y * b.y) : (a.x * b.y + a.y * b.x); }
                    BT1[(size_t)g * 65536 + idx] = (bf16_t)f2bf(v);
                }
                __syncthreads();
            }
        }
        {
            LAS float* scr = (LAS float*)(lds + wave * 16384);
            constexpr int NI0 = 64 * 256, NI1 = 32 * 64, NI2 = 64 * 128, NI3 = 64 * 512, NI4 = 256 * 128, NI5 = 64 * 8 * ((FOX_IN / 32 + 7) / 8), NI6 = 64 * 128, NI7 = NI3, NI8 = NI4;
            constexpr int NITOT = NI0 + NI1 + NI2 + NI3 + NI4 + NI5 + NI6 + NI7 + NI8;
            for (int it = gw; it < NITOT; it += NGW) {
                int r = it; const float* src; bf16_t* dst; int KK, NN; const float* gam = nullptr; const float* bet = nullptr; float* sd = nullptr;
                if (r < NI0) { src = INP(1); KK = 4096; NN = 8192; dst = WSP(bf16_t, WS_W_IN0); }
                else if ((r -= NI0) < NI1) { src = INP(10); KK = 2048; NN = 2048; dst = WSP(bf16_t, WS_W_GLU); }
                else if ((r -= NI1) < NI2) { src = INP(11); KK = 4096; NN = 4096; dst = WSP(bf16_t, WS_W_OUT0); }
                else if ((r -= NI2) < NI3) { src = INP(17); KK = 4096; NN = 16384; dst = WSP(bf16_t, WS_W1_0); gam = INP(15); bet = INP(16); sd = WSP(float, WS_ST); }
                else if ((r -= NI3) < NI4) { src = INP(18); KK = 16384; NN = 4096; dst = WSP(bf16_t, WS_W2_0); }
                else if ((r -= NI4) < NI5) { src = INP(12); KK = 4096; NN = FOX_IN; dst = WSP(bf16_t, WS_W_IN1); gam = INP(19); bet = INP(20); sd = WSP(float, WS_ST) + 2 * ST_N; }
                else if ((r -= NI5) < NI6) { src = INP(14); KK = 4096; NN = 4096; dst = WSP(bf16_t, WS_W_OUT1); }
                else if ((r -= NI6) < NI7) { src = INP(17) + (size_t)4096 * 16384; KK = 4096; NN = 16384; dst = WSP(bf16_t, WS_W1_1); gam = INP(15) + DM; bet = INP(16) + DM; sd = WSP(float, WS_ST) + 4 * ST_N; }
                else { r -= NI7; src = INP(18) + (size_t)4096 * 16384; KK = 16384; NN = 4096; dst = WSP(bf16_t, WS_W2_1); }
                transpose_item(src, KK, NN, dst, scr, r, lane, gam, bet, sd);
            }
            { const int n16 = (FOX_INP - FOX_IN) * 4096 / 8; u32x4* z = (u32x4*)(WSP(bf16_t, WS_W_IN1) + (size_t)48 * 256 * 4096);
              for (int i = gw * 64 + lane; i < n16; i += NGW * 64) { const int kt = i / (224 * 8), r = i % (224 * 8); z[(size_t)kt * (256 * 8) + 32 * 8 + r] = (u32x4){0u, 0u, 0u, 0u}; } }
            { const int n8 = MTOK * DM / 8; const f32x4* x4 = (const f32x4*)INP(0); u32x4* xb = WSP(u32x4, WS_XB);
              for (int i = gw * 64 + lane; i < n8; i += NGW * 64) { const f32x4 a = x4[2 * i], b = x4[2 * i + 1];
                  const int row = i >> 9, c8 = i & 511;
                  xb[(size_t)(row >> 8) * (BM_ * DM / 8) + (size_t)(c8 >> 3) * (BM_ * 8) + (row & 255) * 8 + (c8 & 7)] = pack8f(a, b); } }
        }
        __syncthreads();
        if (BOTH(0)) GRID_BAR();
    }
    for (int rep_ = 0; rep_ < NREP(1); ++rep_) if (IN(1)) {
        WSBASE();
        pg8::Gemm g{WSP(bf16_t, WS_XB), WSP(bf16_t, WS_W_IN0), 64, 64, DM, 32768, (size_t)BM_ * DM * 2, 32768, (size_t)BM_ * DM * 2}; pg8::StaticOrder S; S.init(MTOK, EVEN_IN, G, bx);
        pg8::EpiIn0 E{WSP(bf16_t, WS_UA), WSP(bf16_t, WS_QKV0)};
        pg8::gemm_phase<pg8::EpiIn0, pg8::StaticOrder, true>(lds, g, S, E, wave);
        if (BOTH(1)) GRID_BAR();
    }
    for (int rep_ = 0; rep_ < NREP(2); ++rep_) if (IN(2)) {
        { WSBASE(); pg8::Gemm g{WSP(bf16_t, WS_UA), WSP(bf16_t, WS_BT1), UA_LD, 256, 256}; pg8::GroupOrder S; S.init(512, G, bx);
          pg8::EpiS1 E{WSP(float, WS_XLOC)};
          pg8::gemm_phase<pg8::EpiS1, pg8::GroupOrder, true>(lds, g, S, E, wave); }
        VM_WAIT(); __syncthreads();
        {
            const int lane = lane_id(); WSBASE(); const f32x2* A16 = WSP(f32x2, WS_A16); const float* XLOC = WSP(float, WS_XLOC); bf16_t* UA = WSP(bf16_t, WS_UA);
            for (int task = bx + wave * G; task < 512; task += NWAVES * G) {
                const int g = task >> 2, b = task & 3, n = lane;
                const f32x2 a16 = A16[g * 64 + n];
                const size_t row0 = (size_t)g * 1024 + b * 256;
                float xr = 0.f, xi = 0.f;
                const float* xl = XLOC + row0 * 128 + n;
                float lr[32], li[32];
#pragma unroll
                for (int k = 0; k < 32; ++k) { lr[k] = xl[(size_t)k * 128]; li[k] = xl[(size_t)k * 128 + 64]; }
                for (int c0 = 0; c0 < 256; c0 += 32) {
                    float nr_[32], ni_[32];
                    const int cn = (c0 + 32 < 256) ? c0 + 32 : c0;
#pragma unroll
                    for (int k = 0; k < 32; ++k) { nr_[k] = xl[(size_t)(cn + k) * 128]; ni_[k] = xl[(size_t)(cn + k) * 128 + 64]; }
#pragma unroll
                    for (int k = 0; k < 32; ++k) {
                        bf16_t* dst = UA + (row0 + c0 + k) * UA_LD + 256;
                        dst[n] = (bf16_t)f2bf(xr); dst[64 + n] = (bf16_t)f2bf(xi);
                        const float nr = a16.x * xr - a16.y * xi + lr[k], ni = a16.x * xi + a16.y * xr + li[k];
                        xr = nr; xi = ni;
                    }
#pragma unroll
                    for (int k = 0; k < 32; ++k) { lr[k] = nr_[k]; li[k] = ni_[k]; }
                }
            }
        }
        VM_WAIT(); __syncthreads();
        { WSBASE(); pg8::Gemm g{WSP(bf16_t, WS_UA), WSP(bf16_t, WS_BT2), UA_LD, UA_LD, UA_LD}; pg8::GroupOrder S; S.init(512, G, bx);
          pg8::EpiS2 E{WSP(bf16_t, WS_UA), INP(9), WSP(bf16_t, WS_GACT)};
          pg8::gemm_phase<pg8::EpiS2, pg8::GroupOrder, true>(lds, g, S, E, wave); }
        {
            WSBASE(); const bf16_t* QKV0 = WSP(bf16_t, WS_QKV0); bf16_t* CONCAT = WSP(bf16_t, WS_CONCAT);
            for (int L = bx; L < NB * SB_H * (SEQ / 256); L += G) {
                const int qb = ((L >> 8) & 1) ? 15 - (L & 15) : (L & 15), bh = L >> 4, b = bh >> 4, h = bh & 15;
                const size_t tok0 = (size_t)b * SEQ;
                const bf16_t* Qb = QKV0 + (tok0 + qb * 256) * QKV0_LD + h * HD;
                const bf16_t* Kh = QKV0 + tok0 * QKV0_LD + 2048 + h * HD;
                const bf16_t* Vh = QKV0 + tok0 * QKV0_LD + 4096 + h * HD;
                bf16_t* Ob = CONCAT + (tok0 + qb * 256) * DM + W_SSM + h * HD;
                att::sb_block(Qb, Kh, Vh, Ob, qb * 256, (char*)lds_raw, lds, wave);
            }
        }
        if (BOTH(2)) GRID_BAR();
    }
    for (int rep_ = 0; rep_ < NREP(5); ++rep_) if (IN(5)) {
        WSBASE();
        pg8::Gemm g{WSP(bf16_t, WS_GACT), WSP(bf16_t, WS_W_GLU), W_SSM, 64, W_SSM, pg8::BK * 2, 0, 32768, (size_t)BM_ * W_SSM * 2}; pg8::StaticOrder S; S.init(MTOK, W_SSM, G, bx);
        pg8::EpiGlu E{WSP(bf16_t, WS_GACT), WSP(bf16_t, WS_CONCAT)};
        pg8::gemm_phase<pg8::EpiGlu, pg8::StaticOrder, true>(lds, g, S, E, wave);
        if (BOTH(5)) GRID_BAR();
    }
    for (int rep_ = 0; rep_ < NREP(6); ++rep_) if (IN(6)) {
        WSBASE();
        pg8::Gemm g{WSP(bf16_t, WS_CONCAT), WSP(bf16_t, WS_W_OUT0), DM, 64, DM, pg8::BK * 2, 0, 32768, (size_t)BM_ * DM * 2}; pg8::StaticOrder S; S.init(MTOK, DM, G, bx);
        pg8::EpiResLN<2, false> E{nullptr, WSP(bf16_t, WS_XB), nullptr, nullptr, 0, nullptr, nullptr, WSP(f32x2, WS_PS)};
        pg8::gemm_phase<pg8::EpiResLN<2, false>, pg8::StaticOrder, true>(lds, g, S, E, wave);
        if (BOTH(6)) GRID_BAR();
    }
    for (int rep_ = 0; rep_ < NREP(8); ++rep_) if (IN(8)) {
        WSBASE();
        pg8::Gemm g{WSP(bf16_t, WS_XB), WSP(bf16_t, WS_W1_0), 64, 64, DM, 32768, (size_t)BM_ * DM * 2, 32768, (size_t)BM_ * DM * 2}; pg8::StaticOrder S; S.init(MTOK, DFF, G, bx);
        pg8::EpiLN<1, DFF, true> E{WSP(bf16_t, WS_HID), WSP(f32x2, WS_PS), 0, WSP(float, WS_ST), WSP(float, WS_ST) + ST_N};
        pg8::gemm_phase<pg8::EpiLN<1, DFF, true>, pg8::StaticOrder, true>(lds, g, S, E, wave);
        if (BOTH(8)) GRID_BAR();
    }
    for (int rep_ = 0; rep_ < NREP(9); ++rep_) if (IN(9)) {
        WSBASE();
        pg8::Gemm g{WSP(bf16_t, WS_HID), WSP(bf16_t, WS_W2_0), 64, 64, DFF, 32768, (size_t)BM_ * DFF * 2, 32768, (size_t)BM_ * DFF * 2};   pg8::StaticOrder S; S.init(MTOK, DM, G, bx);
        pg8::EpiResLN<1, false> E{nullptr, WSP(bf16_t, WS_XB), nullptr, WSP(f32x2, WS_PS), 0, INP(15), INP(16), WSP(f32x2, WS_PS) + PS_STRIDE};
        pg8::gemm_phase<pg8::EpiResLN<1, false>, pg8::StaticOrder, true>(lds, g, S, E, wave);
        if (BOTH(9)) GRID_BAR();
    }
    for (int rep_ = 0; rep_ < NREP(11); ++rep_) if (IN(11)) {
        WSBASE();
        pg8::Gemm g{WSP(bf16_t, WS_XB), WSP(bf16_t, WS_W_IN1), 64, 64, DM, 32768, (size_t)BM_ * DM * 2, 32768, (size_t)BM_ * DM * 2}; pg8::StaticOrder S; S.init(MTOK, FOX_INP, G, bx);
        pg8::EpiIn1LN E{WSP(bf16_t, WS_QKV1), WSP(float, WS_FLOG), WSP(f32x2, WS_PS) + PS_STRIDE, 1, WSP(float, WS_ST) + 2 * ST_N, WSP(float, WS_ST) + 3 * ST_N};
        pg8::gemm_phase<pg8::EpiIn1LN, pg8::StaticOrder, true>(lds, g, S, E, wave);
        if (BOTH(11)) GRID_BAR();
    }
    for (int rep_ = 0; rep_ < NREP(12); ++rep_) if (IN(12)) {
        TIDLANE(); WSBASE(); const float* FLOG = WSP(float, WS_FLOG); float* CB = WSP(float, WS_CB); const float* fox_b_f = INP(13);
        {
            const bf16_t* QKV1 = WSP(bf16_t, WS_QKV1); unsigned* NRM = WSP(unsigned, WS_NRM);
            LAS float* red = (LAS float*)(lds + 1024);
            for (int rb = bx; rb < MTOK / 64; rb += G) {
                float mq[8], mk[8], md[8];
#pragma unroll
                for (int j = 0; j < 8; ++j) { mq[j] = 0.f; mk[j] = 0.f; md[j] = 0.f; }
                for (int i = 0; i < 8; ++i) {
                    const u32x4* rowp = (const u32x4*)(QKV1 + (size_t)(rb * 64 + wave * 8 + i) * QKV1_LD) + lane;
#pragma unroll
                    for (int j = 0; j < 8; ++j) {
                        const u32x4 a = rowp[64 * j], c = rowp[512 + 64 * j];
                        float sq = 0.f, sk = 0.f, sd = 0.f;
#pragma unroll
                        for (int e = 0; e < 4; ++e) { const float a0 = bf_lo(a[e]), a1 = bf_hi(a[e]), c0 = bf_lo(c[e]), c1 = bf_hi(c[e]); sq += a0 * a0 + a1 * a1; sk += c0 * c0 + c1 * c1; sd += a0 * c0 + a1 * c1; }
#pragma unroll
                        for (int o = 1; o < 16; o <<= 1) { sq += __shfl_xor(sq, o); sk += __shfl_xor(sk, o); sd += __shfl_xor(sd, o); }
                        mq[j] = fmaxf(mq[j], sq); mk[j] = fmaxf(mk[j], sk); md[j] = fminf(md[j], sd);
                    }
                }
                if ((lane & 15) == 0) {
#pragma unroll
                    for (int j = 0; j < 8; ++j) { red[wave * 64 + j * 4 + (lane >> 4)] = mq[j]; red[wave * 64 + 32 + j * 4 + (lane >> 4)] = mk[j]; red[512 + wave * 32 + j * 4 + (lane >> 4)] = md[j]; }
                }
                __syncthreads();
                if (tid < 64) { float m = red[tid];
#pragma unroll
                    for (int w = 1; w < 8; ++w) m = fmaxf(m, red[w * 64 + tid]);
                    const int b = (rb * 64) >> 12;
                    atomicMax(NRM + (tid >> 5) * 128 + b * 32 + (tid & 31), __float_as_uint(m)); }
                else if (tid < 96) { const int h = tid - 64; float m = red[512 + h];
#pragma unroll
                    for (int w = 1; w < 8; ++w) m = fminf(m, red[512 + w * 32 + h]);
                    const int b = (rb * 64) >> 12, qb = ((rb * 64) & (SEQ - 1)) >> 8; int key = __float_as_int(m); if (key < 0) key ^= 0x7fffffff;
                    atomicMin(WSP(int, WS_DMIN) + (b * 32 + h) * 16 + qb, key); }
                __syncthreads();
            }
        }
        LAS float* wsum = (LAS float*)lds;
        for (int bh = bx; bh < NB * FOX_H; bh += G) {
            const int b = bh >> 5, h = bh & 31; const float bf = fox_b_f[h];
            float v[8]; float run = 0.f;
#pragma unroll
            for (int i = 0; i < 8; ++i) { const float xx = FLOG[(size_t)bh * SEQ + tid * 8 + i] + bf;
                const float ls = fminf(xx, 0.f) - 0.6931471805599453f * __builtin_amdgcn_logf(1.0f + __builtin_amdgcn_exp2f(-fabsf(xx) * 1.4426950408889634f));
                run += ls; v[i] = run; }
            float inc = run;
#pragma unroll
            for (int o = 1; o < 64; o <<= 1) { const float t = __shfl_up(inc, o); if (lane >= o) inc += t; }
            if (lane == 63) wsum[wave] = inc;
            __syncthreads();
            float base = inc - run;
            for (int w = 0; w < wave; ++w) base += wsum[w];
#pragma unroll
            for (int i = 0; i < 8; ++i) CB[(size_t)bh * SEQ + tid * 8 + i] = -(base + v[i]) * 11.313708498984761f;
            __syncthreads();
        }
        if (BOTH(12)) GRID_BAR();
    }
    for (int rep_ = 0; rep_ < NREP(13); ++rep_) if (IN(13)) {
        WSBASE(); const bf16_t* QKV1 = WSP(bf16_t, WS_QKV1); bf16_t* ATT = WSP(bf16_t, WS_ATT); const float* CB = WSP(float, WS_CB);
        const int total = NB * FOX_H * 8;
        if (bx < total) {
            volatile LAS int* JLO = (volatile LAS int*)(lds + MISC_OFF) + 16;
            {
                const int lane = lane_id(); int bh, y;
                if (att::fox_item(bx, wave >> 1, G, total, bh, y)) {
                    const int qb = (wave & 1) ? 15 - y : y, P0 = qb * 256;
                    const unsigned* NRM = WSP(unsigned, WS_NRM);
                    const float qk = sqrtf(__uint_as_float(NRM[bh]) * __uint_as_float(NRM[128 + bh])) * 1.0001f;
                    int dk = WSP(int, WS_DMIN)[bh * 16 + qb]; if (dk < 0) dk ^= 0x7fffffff; const float dmin = fminf(__int_as_float(dk), 0.f);
                    const float cbe = CB[(size_t)bh * SEQ + lane * 64 + 63], base = dmin - qk - 340.f;
#pragma unroll
                    for (int s_ = 0; s_ < 8; ++s_) {
                        const int r0 = P0 + 32 * s_; const float thr = CB[(size_t)bh * SEQ + r0] + base;
                        const bool prun = (lane * 64 + 63 < r0) && (cbe < thr);
                        const unsigned long long mask = __ballot(prun);
                        const int js = (int)__builtin_ctzll(~mask);
                        if (lane == 0) JLO[wave * 8 + s_] = js;
                    }
                } else if (lane < 8) JLO[wave * 8 + lane] = 0;
            }
            __syncthreads();
            att::Seam S; int bh_loaded = -1;
            int k = 0, pass = 0, slot = 0, bh, y, bhn, yn;
            (void)att::fox_item(bx, 0, G, total, bh, y);
            att::BlockRef cur = att::fox_ref(bh, y, 0, QKV1, ATT, CB, __builtin_amdgcn_readfirstlane(JLO[0]));
            att::fox_prime(cur, (char*)lds_raw, S, wave);
            for (;;) {
                const bool more_pass = pass == 0, more_item = att::fox_item(bx, k + 1, G, total, bhn, yn), last = !more_pass && !more_item;
                int passn = 1, kn = k;
                if (more_pass) { bhn = bh; yn = y; } else { passn = 0; kn = k + 1; }
                const int jn = slot + 1 < NWAVES ? __builtin_amdgcn_readfirstlane(JLO[(slot + 1) * 8]) : 0;
                const int jw = slot < NWAVES ? __builtin_amdgcn_readfirstlane(JLO[slot * 8 + wave]) : 0;
                const att::BlockRef nxt = last ? cur : att::fox_ref(bhn, yn, passn, QKV1, ATT, CB, jn);
                att::fox_block(cur, nxt, (char*)lds_raw, S, bh_loaded, wave, jw, lds);
                if (last) break;
                cur = nxt; bh = bhn; y = yn; k = kn; pass = passn; ++slot;
            }
            VM_WAIT(); __syncthreads();
        }
        if (BOTH(13)) GRID_BAR();
    }
    for (int rep_ = 0; rep_ < NREP(14); ++rep_) if (IN(14)) {
        WSBASE();
        pg8::Gemm g{WSP(bf16_t, WS_ATT), WSP(bf16_t, WS_W_OUT1), DM, 64, DM, pg8::BK * 2, 0, 32768, (size_t)BM_ * DM * 2}; pg8::StaticOrder S; S.init(MTOK, DM, G, bx);
        pg8::EpiResLN<1, false> E{nullptr, WSP(bf16_t, WS_XB), nullptr, WSP(f32x2, WS_PS) + PS_STRIDE, 1, INP(19), INP(20), WSP(f32x2, WS_PS) + 2 * PS_STRIDE};
        pg8::gemm_phase<pg8::EpiResLN<1, false>, pg8::StaticOrder, true>(lds, g, S, E, wave);
        if (BOTH(14)) GRID_BAR();
    }
    for (int rep_ = 0; rep_ < NREP(16); ++rep_) if (IN(16)) {
        WSBASE();
        pg8::Gemm g{WSP(bf16_t, WS_XB), WSP(bf16_t, WS_W1_1), 64, 64, DM, 32768, (size_t)BM_ * DM * 2, 32768, (size_t)BM_ * DM * 2}; pg8::StaticOrder S; S.init(MTOK, DFF, G, bx);
        pg8::EpiLN<1, DFF, true> E{WSP(bf16_t, WS_HID), WSP(f32x2, WS_PS) + 2 * PS_STRIDE, 2, WSP(float, WS_ST) + 4 * ST_N, WSP(float, WS_ST) + 5 * ST_N};
        pg8::gemm_phase<pg8::EpiLN<1, DFF, true>, pg8::StaticOrder, true>(lds, g, S, E, wave);
        if (BOTH(16)) GRID_BAR();
    }
    for (int rep_ = 0; rep_ < NREP(17); ++rep_) if (IN(17)) {
        WSBASE();
        pg8::Gemm g{WSP(bf16_t, WS_HID), WSP(bf16_t, WS_W2_1), 64, 64, DFF, 32768, (size_t)BM_ * DFF * 2, 32768, (size_t)BM_ * DFF * 2};   pg8::StaticOrder S; S.init(MTOK, DM, G, bx);
        pg8::EpiResLN<1, false> E{nullptr, WSP(bf16_t, WS_XB), nullptr, WSP(f32x2, WS_PS) + 2 * PS_STRIDE, 2, INP(15) + DM, INP(16) + DM, WSP(f32x2, WS_PS) + 3 * PS_STRIDE};
        pg8::gemm_phase<pg8::EpiResLN<1, false>, pg8::StaticOrder, true>(lds, g, S, E, wave);
        if (BOTH(17)) GRID_BAR();
    }
    for (int rep_ = 0; rep_ < NREP(18); ++rep_) if (IN(18)) { WSBASE(); ln_final(WSP(bf16_t, WS_XB), PSCR(18) ? WSP(float, WS_SCR) : outp, WSP(f32x2, WS_PS) + 3 * PS_STRIDE, INP(19) + DM, INP(20) + DM, lds, gw, NGW, wave); }
#undef IN
#undef BOTH
}

extern "C" void kernel_launch(void* const* d_in, const int* in_sizes, int n_in, void* d_out, int out_size, void* d_ws, size_t ws_size, hipStream_t stream) {
    static int grid = 0;
    if (grid == 0) {
        if (n_in != 21 || out_size != MTOK * DM || ws_size < WS_NEED + ((PROBE_REP) >= 0 ? 384 * MiB : 0)) { fprintf(stderr, "kernel_launch: unexpected shapes (n_in %d, out %d, ws %zu, need %zu)\n", n_in, out_size, ws_size, (size_t)WS_END); grid = -1; return; }
        int dev = 0, cus = 0, per_cu = 0;
        if (hipGetDevice(&dev) != hipSuccess || hipDeviceGetAttribute(&cus, hipDeviceAttributeMultiprocessorCount, dev) != hipSuccess) { grid = -1; return; }
        if (hipFuncSetAttribute((const void*)mega_fwd, hipFuncAttributeMaxDynamicSharedMemorySize, LDS_BYTES) != hipSuccess) { fprintf(stderr, "kernel_launch: hipFuncSetAttribute failed\n"); grid = -1; return; }
        if (hipOccupancyMaxActiveBlocksPerMultiprocessor(&per_cu, (const void*)mega_fwd, NTHR, LDS_BYTES) != hipSuccess || per_cu < 1)
            fprintf(stderr, "kernel_launch: occupancy query reports %d blocks per CU\n", per_cu);
        (void)hipGetLastError();
        grid = cus;
    }
    if (grid < 0) return;
    (void)hipMemsetAsync((char*)d_ws + WS_CTL, 0, CTL_ZERO_BYTES, stream);
    Args a{};
    for (int i = 0; i < 21; ++i) a.in[i] = (const float*)d_in[i];
    a.out = (float*)d_out; a.ws = (unsigned char*)d_ws;
#if MK_ONE_LAUNCH
    a.ph_lo = 0; a.ph_hi = N_PHASES;
    hipLaunchKernelGGL(mega_fwd, dim3(grid), dim3(NTHR), LDS_BYTES, stream, a);
#else
    for (int p = 0; p < N_PHASES; ++p) { a.ph_lo = p; a.ph_hi = p + 1; hipLaunchKernelGGL(mega_fwd, dim3(grid), dim3(NTHR), LDS_BYTES, stream, a); }
#endif
}
```
